# Optimizing an MI355X kernel written in HIP

```python
import jax, jax.numpy as jnp
from jax import lax
import numpy as np

D_MODEL = 1024
BATCH = 4
SEQ = 8192
DEPTH = 1

SSM_HEADDIM = 64
SSM_HEADS = 16
SSM_INNER = SSM_HEADS * SSM_HEADDIM
SSM_GROUPS = 2
SSM_HPG = SSM_HEADS // SSM_GROUPS
SSM_STATE = 64
CONV_K = 4
CHUNK = 128
CONV_DIM = SSM_INNER + 2 * SSM_GROUPS * SSM_STATE

ATT_HEADS = 8
ATT_HEADDIM = 128
ATT_INNER = ATT_HEADS * ATT_HEADDIM
Q_BLOCK = 128

N_BRANCHES = 2
EPS = 1e-6

IN_SPLITS = (SSM_INNER, CONV_DIM, SSM_HEADS, ATT_INNER, ATT_INNER, ATT_INNER, ATT_INNER, ATT_HEADS, N_BRANCHES * D_MODEL)
IN_COLS = int(sum(IN_SPLITS))

kernel_name = "hybrid_ssd_fox_gated_block"


def _rmsnorm(x, w):
    xf = x.astype(jnp.float32)
    y = xf * lax.rsqrt(jnp.mean(xf * xf, axis=-1, keepdims=True) + EPS)
    return (y * w.astype(jnp.float32)).astype(x.dtype)


def _causal_depthwise_conv(u, w, b):
    ch = u.shape[-1]
    out = lax.conv_general_dilated(
        u, w[:, None, :].astype(u.dtype), window_strides=(1,), padding=[(CONV_K - 1, 0)],
        dimension_numbers=("NWC", "WIO", "NWC"), feature_group_count=ch)
    return out + b.astype(u.dtype)


def _ssd_branch(z, xbc, dt_raw, conv_w, conv_b, dt_bias, a_log, d_skip, ssm_norm_w):
    bsz, s, _ = xbc.shape
    g, r, p, n = SSM_GROUPS, SSM_HPG, SSM_HEADDIM, SSM_STATE
    nc = s // CHUNK
    xbc = jax.nn.silu(_causal_depthwise_conv(xbc, conv_w, conv_b))
    xs, bm, cm = jnp.split(xbc, [SSM_INNER, SSM_INNER + g * n], axis=-1)
    xs = xs.reshape(bsz, s, g, r, p)
    dt = jax.nn.softplus(dt_raw.astype(jnp.float32) + dt_bias.astype(jnp.float32)).reshape(bsz, s, g, r)
    a = dt * (-jnp.exp(a_log.astype(jnp.float32))).reshape(g, r)
    xdt = xs.astype(jnp.float32) * dt[..., None]
    xc = xdt.reshape(bsz, nc, CHUNK, g, r, p)
    bc = bm.astype(jnp.float32).reshape(bsz, nc, CHUNK, g, n)
    cc = cm.astype(jnp.float32).reshape(bsz, nc, CHUNK, g, n)
    ac = a.reshape(bsz, nc, CHUNK, g, r).transpose(0, 3, 4, 1, 2)
    a_cs = jnp.cumsum(ac, axis=-1)
    tril = jnp.tril(jnp.ones((CHUNK, CHUNK), dtype=bool))
    seg = a_cs[..., :, None] - a_cs[..., None, :]
    lmat = jnp.exp(jnp.where(tril, seg, -jnp.inf))
    cb = jnp.einsum("bclgn,bcsgn->bgcls", cc, bc)
    y_diag = jnp.einsum("bgrcls,bcsgrp->bclgrp", cb[:, :, None] * lmat, xc)
    decay_states = jnp.exp(a_cs[..., -1:] - a_cs)
    states = jnp.einsum("bclgn,bgrcl,bclgrp->bcgrpn", bc, decay_states, xc)
    states = jnp.concatenate([jnp.zeros_like(states[:, :1]), states], axis=1)
    cs = jnp.cumsum(jnp.pad(a_cs[..., -1], ((0, 0), (0, 0), (0, 0), (1, 0))), axis=-1)
    tril_c = jnp.tril(jnp.ones((nc + 1, nc + 1), dtype=bool))
    decay_chunk = jnp.exp(jnp.where(tril_c, cs[..., :, None] - cs[..., None, :], -jnp.inf))
    new_states = jnp.einsum("bgrzc,bcgrpn->bzgrpn", decay_chunk, states)
    prev_states = new_states[:, :-1]
    y_off = jnp.einsum("bclgn,bcgrpn,bgrcl->bclgrp", cc, prev_states, jnp.exp(a_cs))
    y = (y_diag + y_off).reshape(bsz, s, g, r, p) + d_skip.astype(jnp.float32).reshape(g, r)[..., None] * xs.astype(jnp.float32)
    y = y.reshape(bsz, s, SSM_INNER).astype(z.dtype)
    return _rmsnorm(y * jax.nn.silu(z), ssm_norm_w)


def _fox_branch(q, k, v, z, f_logit, b_f):
    bsz, s, _ = q.shape
    nb = s // Q_BLOCK
    q = q.reshape(bsz, s, ATT_HEADS, ATT_HEADDIM).transpose(0, 2, 1, 3)
    k = k.reshape(bsz, s, ATT_HEADS, ATT_HEADDIM).transpose(0, 2, 1, 3)
    v = v.reshape(bsz, s, ATT_HEADS, ATT_HEADDIM).transpose(0, 2, 1, 3)
    log_f = jax.nn.log_sigmoid(f_logit.astype(jnp.float32) + b_f.astype(jnp.float32))
    f_cum = jnp.cumsum(log_f, axis=1).transpose(0, 2, 1)
    scale = ATT_HEADDIM ** -0.5
    qb = q.reshape(bsz, ATT_HEADS, nb, Q_BLOCK, ATT_HEADDIM).transpose(2, 0, 1, 3, 4)
    fq = f_cum.reshape(bsz, ATT_HEADS, nb, Q_BLOCK).transpose(2, 0, 1, 3)
    qpos = jnp.arange(s, dtype=jnp.int32).reshape(nb, Q_BLOCK)
    kpos = jnp.arange(s, dtype=jnp.int32)

    def one_block(args):
        qi, fi, pi = args
        logits = jnp.einsum("bhqd,bhkd->bhqk", qi, k).astype(jnp.float32) * scale
        logits = logits + fi[..., :, None] - f_cum[..., None, :]
        logits = jnp.where(pi[:, None] >= kpos[None, :], logits, -jnp.inf)
        probs = jax.nn.softmax(logits, axis=-1).astype(v.dtype)
        return jnp.einsum("bhqk,bhkd->bhqd", probs, v)

    o = lax.map(one_block, (qb, fq, qpos))
    o = o.transpose(1, 0, 3, 2, 4).reshape(bsz, s, ATT_INNER)
    return o * jax.nn.silu(z)


def setup_inputs(seed: int = 0) -> dict:
    key = jax.random.key(seed)
    ks = jax.random.split(key, 20)
    d = D_MODEL
    x = jax.random.normal(ks[0], (BATCH, SEQ, d), jnp.float32)
    c = jax.random.normal(ks[1], (BATCH, d), jnp.float32)
    w_ada = jax.random.normal(ks[2], (d, 3 * d), jnp.float32) * d ** -0.5 * 0.5
    b_ada = jax.random.normal(ks[3], (3 * d,), jnp.float32) * 0.01
    norm_w = 1.0 + 0.05 * jax.random.normal(ks[4], (d,), jnp.float32)
    w_in = jax.random.normal(ks[5], (d, IN_COLS), jnp.float32) * d ** -0.5
    conv_w = jax.random.normal(ks[6], (CONV_K, CONV_DIM), jnp.float32) * 0.5
    conv_b = jax.random.normal(ks[7], (CONV_DIM,), jnp.float32) * 0.02
    dt0 = jnp.exp(jax.random.uniform(ks[8], (SSM_HEADS,), jnp.float32, np.log(1e-3), np.log(1e-1)))
    dt_bias = dt0 + jnp.log(-jnp.expm1(-dt0))
    a_log = jnp.log(jax.random.uniform(ks[9], (SSM_HEADS,), jnp.float32, 1.0, 16.0))
    d_skip = 1.0 + 0.1 * jax.random.normal(ks[10], (SSM_HEADS,), jnp.float32)
    ssm_norm_w = 1.0 + 0.05 * jax.random.normal(ks[11], (SSM_INNER,), jnp.float32)
    b_f = jnp.linspace(1.0, 6.0, ATT_HEADS, dtype=jnp.float32) + 0.1 * jax.random.normal(ks[12], (ATT_HEADS,), jnp.float32)
    b_gate = jax.random.normal(ks[13], (N_BRANCHES * d,), jnp.float32) * 0.01
    w_proj_ssm = jax.random.normal(ks[14], (SSM_INNER, d), jnp.float32) * SSM_INNER ** -0.5
    w_proj_att = jax.random.normal(ks[15], (ATT_INNER, d), jnp.float32) * ATT_INNER ** -0.5
    w_out = jax.random.normal(ks[16], (d, d), jnp.float32) * d ** -0.5
    final_norm_w = 1.0 + 0.05 * jax.random.normal(ks[17], (d,), jnp.float32)
    return {"x": x, "c": c, "w_ada": w_ada, "b_ada": b_ada, "norm_w": norm_w, "w_in": w_in,
            "conv_w": conv_w, "conv_b": conv_b, "dt_bias": dt_bias, "a_log": a_log, "d_skip": d_skip,
            "ssm_norm_w": ssm_norm_w, "b_f": b_f, "b_gate": b_gate, "w_proj_ssm": w_proj_ssm,
            "w_proj_att": w_proj_att, "w_out": w_out, "final_norm_w": final_norm_w}


def reference(x, c, w_ada, b_ada, norm_w, w_in, conv_w, conv_b, dt_bias, a_log, d_skip,
              ssm_norm_w, b_f, b_gate, w_proj_ssm, w_proj_att, w_out, final_norm_w):
    ada = jax.nn.silu(c) @ w_ada + b_ada
    shift, scale, gate = jnp.split(ada, 3, axis=-1)
    offsets = [int(o) for o in np.cumsum(IN_SPLITS)[:-1]]
    for _ in range(DEPTH):
        h = _rmsnorm(x, norm_w) * (1.0 + scale[:, None, :]) + shift[:, None, :]
        proj = jnp.einsum("bsd,de->bse", h, w_in)
        z_ssm, xbc, dt_raw, q, k, v, z_att, f_logit, g_logit = jnp.split(proj, offsets, axis=-1)
        y_ssm = _ssd_branch(z_ssm, xbc, dt_raw, conv_w, conv_b, dt_bias, a_log, d_skip, ssm_norm_w)
        y_att = _fox_branch(q, k, v, z_att, f_logit, b_f)
        g_ssm, g_att = jnp.split(jax.nn.sigmoid(g_logit + b_gate), N_BRANCHES, axis=-1)
        merged = g_ssm * jnp.einsum("bse,ed->bsd", y_ssm, w_proj_ssm) + g_att * jnp.einsum("bse,ed->bsd", y_att, w_proj_att)
        x = x + gate[:, None, :] * jnp.einsum("bsd,de->bse", merged, w_out)
    return _rmsnorm(x, final_norm_w)
```

```cpp
#include <hip/hip_runtime.h>
#include <hip/hip_cooperative_groups.h>
#include <cstdio>
#include <cstdint>
namespace cg = cooperative_groups;

#define LAS __attribute__((address_space(3)))
typedef unsigned short bf16_t;
typedef short bf16x8 __attribute__((ext_vector_type(8)));
typedef short s16x4 __attribute__((ext_vector_type(4)));
typedef float f32x4 __attribute__((ext_vector_type(4)));
typedef float f32x16 __attribute__((ext_vector_type(16)));
typedef unsigned u32x4 __attribute__((ext_vector_type(4)));
typedef unsigned u32x2 __attribute__((ext_vector_type(2)));
typedef float f32x2 __attribute__((ext_vector_type(2)));

#ifndef MK_N_LAUNCHES
#define MK_N_LAUNCHES 1
#endif

constexpr int NB = 4, SEQ = 8192, DM = 1024, M = NB * SEQ;
constexpr int IN_COLS = 8472;
constexpr size_t SEG_ZSSM = 0, SEG_XBC = (size_t)M * 1024, SEG_Q = SEG_XBC + (size_t)M * 1280, SEG_K = SEG_Q + (size_t)M * 1024, SEG_V = SEG_K + (size_t)M * 1024,
                 SEG_ZATT = SEG_V + (size_t)M * 1024, SEG_GSSM = SEG_ZATT + (size_t)M * 1024;
constexpr int XPITCH = 1280;
constexpr int NPROJ = 8448;
constexpr int NHS = 16, NHA = 8, NCH = 64, CHUNK = 128, CONVD = 1280;
constexpr float EPS = 1e-6f;
constexpr float LOG2E = 1.4426950408889634f;

constexpr size_t MiB = 1u << 20;
constexpr size_t WS_P = 0;
constexpr size_t WS_WIN = 464 * MiB;
constexpr size_t WS_WP = 481 * MiB;
constexpr size_t WS_WOUT = 485 * MiB;
constexpr size_t WS_WSMALL = 487 * MiB;
constexpr size_t WS_ADA = 487 * MiB + 128 * 1024;
constexpr size_t WS_DT = 488 * MiB;
constexpr size_t WS_LOGF = 490 * MiB;
constexpr size_t WS_FL = 491 * MiB;
constexpr size_t WS_ACH = 492 * MiB;
constexpr size_t WS_NORM2 = 492 * MiB + 32 * 1024;
constexpr size_t WS_QBD = 492 * MiB + 40 * 1024;
constexpr size_t WS_QCTR = 492 * MiB + 48 * 1024;
constexpr size_t WS_PCNT = 492 * MiB + 64 * 1024;
constexpr size_t WS_SSQ = 493 * MiB;
constexpr size_t WS_SSQ2 = 495 * MiB;
constexpr size_t WS_END = 497 * MiB;
constexpr size_t OUT_H = 0, OUT_ST = 0, OUT_GATT = 64 * MiB;

constexpr int LDS_BYTES = 147456;
constexpr int NTHREADS = 512;

struct Params {
    const float *x, *c, *w_ada, *b_ada, *norm_w, *w_in, *conv_w, *conv_b, *dt_bias, *a_log, *d_skip, *ssm_norm_w, *b_f, *b_gate,
        *w_proj_ssm, *w_proj_att, *w_out, *final_norm_w;
    float* out; unsigned char* ws; int ph_lo, ph_hi;
};

typedef __bf16 bf16v2_t __attribute__((ext_vector_type(2)));
__device__ __forceinline__ unsigned cvt_pk_bf16(float lo, float hi) { const f32x2 v = {lo, hi}; return __builtin_bit_cast(unsigned, __builtin_convertvector(v, bf16v2_t)); }
__device__ __forceinline__ float bf2f(bf16_t v) { return __uint_as_float(((unsigned)v) << 16); }
__device__ __forceinline__ float bflo(unsigned w) { return __uint_as_float(w << 16); }
__device__ __forceinline__ float bfhi(unsigned w) { return __uint_as_float(w & 0xffff0000u); }
__device__ __forceinline__ bf16_t f2bf(float f) { return (bf16_t)(cvt_pk_bf16(f, 0.f) & 0xffffu); }
#define DPPF(v, ctrl) __builtin_bit_cast(float, __builtin_amdgcn_update_dpp(0, __builtin_bit_cast(int, (v)), (ctrl), 0xf, 0xf, true))
__device__ __forceinline__ float wave_sum(float v) {
    v += DPPF(v, 0xB1); v += DPPF(v, 0x4E); v += DPPF(v, 0x141); v += DPPF(v, 0x140);
    { auto rr = __builtin_amdgcn_permlane16_swap(__float_as_uint(v), __float_as_uint(v), false, false); v = __uint_as_float(rr[0]) + __uint_as_float(rr[1]); }
    { auto rr = __builtin_amdgcn_permlane32_swap(__float_as_uint(v), __float_as_uint(v), false, false); v = __uint_as_float(rr[0]) + __uint_as_float(rr[1]); }
    return v;
}
__device__ __forceinline__ int fkey(float f) { const int b = __float_as_int(f); return b >= 0 ? b : b ^ 0x7fffffff; }
__device__ __forceinline__ float fkey_inv(int k) { return __int_as_float(k >= 0 ? k : k ^ 0x7fffffff); }
__device__ __forceinline__ float sigmoidf_(float v) { return __builtin_amdgcn_rcpf(1.f + __expf(-v)); }
__device__ __forceinline__ float siluf_(float v) { return v * __builtin_amdgcn_rcpf(1.f + __expf(-v)); }
#define LDS_WAIT() asm volatile("s_waitcnt lgkmcnt(0)" ::: "memory")
__device__ __forceinline__ int fresh_lane() { int l; asm volatile("v_mbcnt_lo_u32_b32 %0, -1, 0\n\tv_mbcnt_hi_u32_b32 %0, -1, %0" : "=v"(l)); return l; }
__device__ __forceinline__ void grid_barrier(unsigned* bar, unsigned target, int wave) {
    asm volatile("s_waitcnt vmcnt(0)" ::: "memory");
    __syncthreads();
    if (wave == 0 && fresh_lane() == 0) {
        __builtin_amdgcn_fence(__ATOMIC_RELEASE, "agent");
        asm volatile("s_waitcnt vmcnt(0)" ::: "memory");
        __hip_atomic_fetch_add(bar, 1u, __ATOMIC_RELAXED, __HIP_MEMORY_SCOPE_AGENT);
        unsigned spins = 0;
        while (__hip_atomic_load(bar, __ATOMIC_RELAXED, __HIP_MEMORY_SCOPE_AGENT) < target) { __builtin_amdgcn_s_sleep(1); if (++spins > (1u << 22)) break; }
        __builtin_amdgcn_fence(__ATOMIC_ACQUIRE, "agent");
        asm volatile("s_waitcnt vmcnt(0)" ::: "memory");
    }
    __syncthreads();
}

namespace pg8 {
constexpr int BM = 256, BK = 64, HALF = 128, HTB = HALF * BK * 2, STAGE_BYTES = 8 * HTB, NXCD = 8, WGM = 8;
__device__ __forceinline__ int lds_byte(int r, int c) { const int st = (r >> 4) * 2 + (c >> 5), rr = r & 15, cc = c & 31, ob = rr * 64 + cc * 2; return st * 1024 + (ob ^ (((ob >> 9) & 1) << 5)); }
__device__ __forceinline__ void stage_rc(int b, int& R, int& C) { const int st = b / 1024, sb = b % 1024, swz = sb ^ (((sb >> 9) & 1) << 5); R = (st >> 1) * 16 + swz / 64; C = (st & 1) * 32 + (swz % 64) / 2; }
__device__ __forceinline__ int perm32(int rho) { const int n = rho >> 4, i = rho & 15; return 8 * (i >> 2) + 4 * n + (i & 3); }

struct Unit { int pm, pn, br, slot; };
template <int NBR> struct Order {
    int nM, nN, nwg, G, c;
    const char* A0; const char* A1; const char* B; size_t tstepA;
    __device__ void init(int M_, int N_, int G_, int c_) { nM = M_ / BM; nN = N_ / BM; nwg = nM * nN; G = G_; c = c_; }
    __device__ bool next(int i, Unit& u) const {
        const long L = (long)(i / NBR) * G + c; if (L >= nwg) return false;
        int wgid = (int)L; { const int q = nwg / NXCD, r = nwg % NXCD, xcd = wgid % NXCD, off = wgid / NXCD; wgid = (xcd < r ? xcd * (q + 1) : r * (q + 1) + (xcd - r) * q) + off; }
        const int nig = WGM * nN, gid = wgid / nig, fm = gid * WGM, gsz = (nM - fm) < WGM ? (nM - fm) : WGM;
        u.pm = fm + ((wgid % nig) % gsz); u.pn = (wgid % nig) / gsz; u.br = i % NBR; u.slot = i / NBR; return true;
    }
    __device__ __forceinline__ const char* aptr(const Unit& u) const { return (u.br ? A1 : A0) + (size_t)u.pm * tstepA; }
    __device__ __forceinline__ const char* bptr(const Unit& u, int K) const { return B + (size_t)(u.br * nN + u.pn) * (size_t)(BM * K * 2); }
};

template <class Epi, class Sched>
__device__ __forceinline__ void gemm_phase(LAS unsigned char* lds, const int K, const int lda, const Sched& S, const Epi& E, const int wid) {
    const int lane = fresh_lane(), tid = wid * 64 + lane, wr = wid >> 2, wc = wid & 3, fr = lane & 15, fq = lane >> 4;
    const int nt = K / BK;
    unsigned voffA[2], voffB[2];
#pragma unroll
    for (int i = 0; i < 2; ++i) { int R, C; stage_rc(tid * 16 + i * 8192, R, C); const int Rb = (R & ~31) + perm32(R & 31);
        voffA[i] = (unsigned)(R * lda + C) * 2u; voffB[i] = (unsigned)(Rb * K + C) * 2u; }
    const size_t kstep = (size_t)(BK * 2);
    const size_t hstepA = (size_t)HALF * lda * 2, hstepB = (size_t)HALF * K * 2;
    const unsigned ldsw = (unsigned)wid * 1024u;
    const int aoff = lds_byte(wr * 64 + fr, fq * 8), boff = lds_byte(wc * 32 + fr, fq * 8);
#define PG8_SA(b, h) (((b) * 2 + (h)) * HTB)
#define PG8_SB(b, h) ((4 + (b) * 2 + (h)) * HTB)
#define PG8_STAGE(bufoff, gbase, voff) do { _Pragma("unroll") for (int _i = 0; _i < 2; ++_i) \
        __builtin_amdgcn_global_load_lds((const unsigned*)((const char*)(gbase) + (voff)[_i]), (LAS unsigned*)(lds + (bufoff) + ldsw + _i * 8192), 16, 0, 0); } while (0)
#define PG8_LDA(dst, b, h) do { _Pragma("unroll") for (int m = 0; m < 4; ++m) _Pragma("unroll") for (int k = 0; k < 2; ++k) dst[m][k] = *(const LAS bf16x8*)(lds + PG8_SA(b, h) + aoff + m * 2048 + k * 1024); } while (0)
#define PG8_LDB(dst, b, h) do { _Pragma("unroll") for (int n = 0; n < 2; ++n) _Pragma("unroll") for (int k = 0; k < 2; ++k) dst[n][k] = *(const LAS bf16x8*)(lds + PG8_SB(b, h) + boff + n * 2048 + k * 1024); } while (0)
#define PG8_MMA(ai, bj, At, Bt) do { __builtin_amdgcn_s_setprio(1); _Pragma("unroll") for (int m = 0; m < 4; ++m) _Pragma("unroll") for (int n = 0; n < 2; ++n) _Pragma("unroll") for (int k = 0; k < 2; ++k) \
        acc[ai][bj][m][n] = __builtin_amdgcn_mfma_f32_16x16x32_bf16(Bt[n][k], At[m][k], acc[ai][bj][m][n], 0, 0, 0); __builtin_amdgcn_s_setprio(0); } while (0)
#define PG8_WAIT_V(n) asm volatile("s_waitcnt vmcnt(" #n ")" ::: "memory")
#define PG8_WAIT_L(n) asm volatile("s_waitcnt lgkmcnt(" #n ")" ::: "memory")
#define PG8_BAR __builtin_amdgcn_s_barrier()
#define PG8_SCHED __builtin_amdgcn_sched_barrier(0)
    Unit cur, nxt; int ui = 0;
    if (!S.next(0, cur)) return;
    f32x4 acc[2][2][4][2];
#pragma unroll
    for (int a = 0; a < 2; ++a)
#pragma unroll
        for (int b = 0; b < 2; ++b)
#pragma unroll
            for (int m = 0; m < 4; ++m)
#pragma unroll
                for (int n = 0; n < 2; ++n) acc[a][b][m][n] = (f32x4){0.f, 0.f, 0.f, 0.f};
    bf16x8 At[4][2], B0[2][2], B1[2][2];
    const char* cA = S.aptr(cur); const char* cB = S.bptr(cur, K);
    PG8_STAGE(PG8_SB(0, 0), cB, voffB); PG8_STAGE(PG8_SB(0, 1), cB + hstepB, voffB); PG8_STAGE(PG8_SA(0, 0), cA, voffA); PG8_STAGE(PG8_SA(0, 1), cA + hstepA, voffA);
    if (wr == 1) PG8_BAR;
    PG8_WAIT_V(2); PG8_BAR;
    PG8_STAGE(PG8_SB(1, 0), cB + kstep, voffB); PG8_STAGE(PG8_SA(1, 0), cA + kstep, voffA); PG8_STAGE(PG8_SB(1, 1), cB + hstepB + kstep, voffB);
    PG8_WAIT_V(6); PG8_BAR;
    for (;;) {
        const bool has_next = S.next(ui + 1, nxt);
        const char* nA = has_next ? S.aptr(nxt) : cA; const char* nB = has_next ? S.bptr(nxt, K) : cB;
        for (int t = 0; t < nt; t += 2) {
            const bool last = (t == nt - 2);
            const char* a1 = cA + (size_t)(t + 1) * kstep;
            const char* a2 = last ? nA : cA + (size_t)(t + 2) * kstep; const char* b2 = last ? nB : cB + (size_t)(t + 2) * kstep;
            const char* a3 = a2 + kstep; const char* b3 = b2 + kstep;
            PG8_LDB(B0, 0, 0); PG8_LDB(B1, 0, 1); PG8_SCHED; PG8_LDA(At, 0, 0); PG8_STAGE(PG8_SA(1, 1), a1 + hstepA, voffA);
            PG8_WAIT_V(8); PG8_WAIT_L(0); PG8_BAR; PG8_MMA(0, 0, At, B0); PG8_MMA(0, 1, At, B1); PG8_BAR; PG8_SCHED;
            PG8_LDA(At, 0, 1); PG8_STAGE(PG8_SB(0, 0), b2, voffB); PG8_STAGE(PG8_SB(0, 1), b2 + hstepB, voffB); PG8_STAGE(PG8_SA(0, 0), a2, voffA);
            PG8_WAIT_V(8); PG8_WAIT_L(0); PG8_BAR; PG8_MMA(1, 0, At, B0); PG8_MMA(1, 1, At, B1); PG8_BAR; PG8_SCHED;
            PG8_LDB(B0, 1, 0); PG8_LDB(B1, 1, 1); PG8_SCHED; PG8_LDA(At, 1, 0); PG8_STAGE(PG8_SA(0, 1), a2 + hstepA, voffA);
            PG8_WAIT_V(8); PG8_WAIT_L(0); PG8_BAR; PG8_MMA(0, 0, At, B0); PG8_MMA(0, 1, At, B1); PG8_BAR; PG8_SCHED;
            PG8_LDA(At, 1, 1); PG8_STAGE(PG8_SB(1, 0), b3, voffB); PG8_STAGE(PG8_SB(1, 1), b3 + hstepB, voffB); PG8_STAGE(PG8_SA(1, 0), a3, voffA);
            PG8_WAIT_V(8); PG8_WAIT_L(0); PG8_BAR; PG8_MMA(1, 0, At, B0); PG8_MMA(1, 1, At, B1); PG8_BAR; PG8_SCHED;
        }
        if (wr == 0) PG8_BAR;
        E(acc, cur, wr, wc, fr, fq);
        if (!has_next) break;
        if (!(Epi::CHAIN && cur.br == 0)) {
#pragma unroll
        for (int a = 0; a < 2; ++a)
#pragma unroll
            for (int b = 0; b < 2; ++b)
#pragma unroll
                for (int m = 0; m < 4; ++m)
#pragma unroll
                    for (int n = 0; n < 2; ++n) acc[a][b][m][n] = (f32x4){0.f, 0.f, 0.f, 0.f};
        }
        cur = nxt; cA = nA; cB = nB; ++ui;
        if (wr == 1) PG8_BAR;
    }
    PG8_WAIT_V(0);
    PG8_BAR;
#undef PG8_SA
#undef PG8_SB
#undef PG8_STAGE
#undef PG8_LDA
#undef PG8_LDB
#undef PG8_MMA
#undef PG8_WAIT_V
#undef PG8_WAIT_L
#undef PG8_BAR
#undef PG8_SCHED
}

struct EpiProj {
    static constexpr bool CHAIN = false;
    bf16_t* P; bf16_t* GA;
    __device__ __forceinline__ void operator()(const f32x4 (&acc)[2][2][4][2], const Unit& u, int wr, int wc, int fr, int fq) const {
        bf16_t* base; int ld;
        if (u.pn < 4) { base = P + SEG_ZSSM + u.pn * BM; ld = DM; }
        else if (u.pn < 9) { base = P + SEG_XBC + (u.pn - 4) * BM; ld = XPITCH; }
        else if (u.pn < 29) { base = P + SEG_Q + (size_t)((u.pn - 9) >> 2) * ((size_t)M * 1024) + ((u.pn - 9) & 3) * BM; ld = DM; }
        else { base = GA + (u.pn - 29) * BM; ld = DM; }
        const int row0 = u.pm * BM + wr * 64 + fr, col0 = wc * 32 + 8 * fq;
#pragma unroll
        for (int ai = 0; ai < 2; ++ai)
#pragma unroll
            for (int m = 0; m < 4; ++m) { bf16_t* rowp = base + (size_t)(row0 + ai * HALF + m * 16) * ld + col0;
#pragma unroll
                for (int bj = 0; bj < 2; ++bj) { const f32x4 v0 = acc[ai][bj][m][0], v1 = acc[ai][bj][m][1];
                    u32x4 w; w.x = cvt_pk_bf16(v0[0], v0[1]); w.y = cvt_pk_bf16(v0[2], v0[3]); w.z = cvt_pk_bf16(v1[0], v1[1]); w.w = cvt_pk_bf16(v1[2], v1[3]);
                    __builtin_nontemporal_store(w, (u32x4*)(rowp + bj * HALF)); } }
    }
};
struct EpiMerge {
    static constexpr bool CHAIN = true;
    const bf16_t* GS; const bf16_t* GA; bf16_t* MG; const float* rstd_lds; const float* b_gate;
    __device__ __forceinline__ void operator()(f32x4 (&acc)[2][2][4][2], const Unit& u, int wr, int wc, int fr, int fq) const {
        const int row0 = u.pm * BM + wr * 64 + fr, col0 = u.pn * BM + wc * 32 + 8 * fq;
        f32x4 ba[2][2];
#pragma unroll
        for (int bj = 0; bj < 2; ++bj)
#pragma unroll
            for (int n = 0; n < 2; ++n) ba[bj][n] = *(const f32x4*)(b_gate + DM + col0 + bj * HALF + 4 * n);
        u32x4 ga[2][2], gs[2][2];
#define EM_LOAD(slot, r) do { const int row_ = row0 + ((r) >> 2) * HALF + ((r) & 3) * 16; \
            ga[slot][0] = __builtin_nontemporal_load((const u32x4*)(GA + (size_t)row_ * DM + col0)); ga[slot][1] = __builtin_nontemporal_load((const u32x4*)(GA + (size_t)row_ * DM + col0 + HALF)); \
            if (u.br == 0) { gs[slot][0] = __builtin_nontemporal_load((const u32x4*)(GS + (size_t)row_ * DM + col0)); gs[slot][1] = __builtin_nontemporal_load((const u32x4*)(GS + (size_t)row_ * DM + col0 + HALF)); } } while (0)
        EM_LOAD(0, 0);
#pragma unroll
        for (int r = 0; r < 8; ++r) {
            const int sl = r & 1, ai = r >> 2, m = r & 3;
            if (r + 1 < 8) { EM_LOAD(sl ^ 1, r + 1); }
            asm volatile("" ::: "memory");
            const int row = row0 + ai * HALF + m * 16;
            if (u.br == 0) {
                const float rs = rstd_lds[u.slot * 256 + ai * HALF + wr * 64 + m * 16 + fr];
#pragma unroll
                for (int bj = 0; bj < 2; ++bj) {
                    const u32x4 a4 = ga[sl][bj], s4 = gs[sl][bj];
                    f32x4 a0 = {bflo(a4.x), bfhi(a4.x), bflo(a4.y), bfhi(a4.y)}, a1 = {bflo(a4.z), bfhi(a4.z), bflo(a4.w), bfhi(a4.w)};
                    f32x4 s0 = {bflo(s4.x), bfhi(s4.x), bflo(s4.y), bfhi(s4.y)}, s1 = {bflo(s4.z), bfhi(s4.z), bflo(s4.w), bfhi(s4.w)};
                    a0 = a0 + ba[bj][0]; a1 = a1 + ba[bj][1];
                    const f32x4 bs0 = *(const f32x4*)(b_gate + col0 + bj * HALF), bs1 = *(const f32x4*)(b_gate + col0 + bj * HALF + 4);
                    s0 = s0 + bs0; s1 = s1 + bs1;
#pragma unroll
                    for (int e = 0; e < 4; ++e) { s0[e] = sigmoidf_(s0[e]) * rs * (1.f + __expf(-fmaxf(a0[e], -80.f))); s1[e] = sigmoidf_(s1[e]) * rs * (1.f + __expf(-fmaxf(a1[e], -80.f))); }
                    acc[ai][bj][m][0] = acc[ai][bj][m][0] * s0; acc[ai][bj][m][1] = acc[ai][bj][m][1] * s1; }
            } else {
                bf16_t* mp = MG + (size_t)row * DM + col0;
#pragma unroll
                for (int bj = 0; bj < 2; ++bj) {
                    const u32x4 a4 = ga[sl][bj];
                    f32x4 a0 = {bflo(a4.x), bfhi(a4.x), bflo(a4.y), bfhi(a4.y)}, a1 = {bflo(a4.z), bfhi(a4.z), bflo(a4.w), bfhi(a4.w)};
                    a0 = a0 + ba[bj][0]; a1 = a1 + ba[bj][1];
#pragma unroll
                    for (int e = 0; e < 4; ++e) { a0[e] = sigmoidf_(fmaxf(a0[e], -80.f)); a1[e] = sigmoidf_(fmaxf(a1[e], -80.f)); }
                    const f32x4 v0 = a0 * acc[ai][bj][m][0], v1 = a1 * acc[ai][bj][m][1];
                    u32x4 w; w.x = cvt_pk_bf16(v0[0], v0[1]); w.y = cvt_pk_bf16(v0[2], v0[3]); w.z = cvt_pk_bf16(v1[0], v1[1]); w.w = cvt_pk_bf16(v1[2], v1[3]);
                    *(u32x4*)(mp + bj * HALF) = w; }
            }
        }
#undef EM_LOAD
    }
};
struct EpiOutNorm {
    static constexpr bool MUT = true, CHAIN = false;
    const float* x; float* out; const float* ada; float* ssq2; unsigned* cnt; const float* fnw;
    __device__ __forceinline__ void operator()(f32x4 (&acc)[2][2][4][2], const Unit& u, int wr, int wc, int fr, int fq) const {
        const int row0 = u.pm * BM + wr * 64 + fr, col0 = u.pn * BM + wc * 32 + 8 * fq;
        const float* gate = ada + (size_t)(u.pm >> 5) * 3072 + 2048;
        f32x4 gt[2][2];
#pragma unroll
        for (int bj = 0; bj < 2; ++bj)
#pragma unroll
            for (int n = 0; n < 2; ++n) gt[bj][n] = *(const f32x4*)(gate + col0 + bj * HALF + 4 * n);
        f32x4 xv[2][2][2];
#define EO_LOAD(slot, r) do { const size_t off_ = (size_t)(row0 + ((r) >> 2) * HALF + ((r) & 3) * 16) * DM + col0; \
            xv[slot][0][0] = __builtin_nontemporal_load((const f32x4*)(x + off_)); xv[slot][0][1] = __builtin_nontemporal_load((const f32x4*)(x + off_ + 4)); xv[slot][1][0] = __builtin_nontemporal_load((const f32x4*)(x + off_ + HALF)); xv[slot][1][1] = __builtin_nontemporal_load((const f32x4*)(x + off_ + HALF + 4)); } while (0)
        EO_LOAD(0, 0);
#pragma unroll
        for (int r = 0; r < 8; ++r) {
            const int sl = r & 1, ai = r >> 2, m = r & 3;
            if (r + 1 < 8) { EO_LOAD(sl ^ 1, r + 1); }
            const int row = row0 + ai * HALF + m * 16; float s_ = 0.f;
#pragma unroll
            for (int bj = 0; bj < 2; ++bj)
#pragma unroll
                for (int n = 0; n < 2; ++n) { const f32x4 o = xv[sl][bj][n] + gt[bj][n] * acc[ai][bj][m][n]; acc[ai][bj][m][n] = o;
                    s_ += (o[0] * o[0] + o[1] * o[1]) + (o[2] * o[2] + o[3] * o[3]); }
            s_ += __shfl_xor(s_, 16); s_ += __shfl_xor(s_, 32);
            if (fq == 0) __hip_atomic_store(ssq2 + (size_t)row * 16 + u.pn * 4 + wc, s_, __ATOMIC_RELAXED, __HIP_MEMORY_SCOPE_AGENT); }
#undef EO_LOAD
        asm volatile("s_waitcnt vmcnt(0)" ::: "memory");
        unsigned* pc = cnt + 64 * u.pm;
        if ((fr | fq) == 0) __hip_atomic_fetch_add(pc, 1u, __ATOMIC_RELAXED, __HIP_MEMORY_SCOPE_AGENT);
        { unsigned spins = 0;
          while ((unsigned)__builtin_amdgcn_readfirstlane(__hip_atomic_load(pc, __ATOMIC_RELAXED, __HIP_MEMORY_SCOPE_AGENT)) < 32u) { __builtin_amdgcn_s_sleep(1); if (++spins > (1u << 22)) break; } }
        __builtin_amdgcn_fence(__ATOMIC_ACQUIRE, "agent");
        f32x4 fw[2][2];
#pragma unroll
        for (int bj = 0; bj < 2; ++bj)
#pragma unroll
            for (int n = 0; n < 2; ++n) fw[bj][n] = *(const f32x4*)(fnw + col0 + bj * HALF + 4 * n);
#pragma unroll
        for (int r = 0; r < 8; ++r) {
            const int ai = r >> 2, m = r & 3; const int row = row0 + ai * HALF + m * 16; const size_t off = (size_t)row * DM + col0;
            const f32x4* sp = (const f32x4*)(ssq2 + (size_t)row * 16); const f32x4 a = sp[0], b = sp[1], c = sp[2], d = sp[3];
            const float t = ((a[0] + a[1]) + (a[2] + a[3])) + ((b[0] + b[1]) + (b[2] + b[3])) + ((c[0] + c[1]) + (c[2] + c[3])) + ((d[0] + d[1]) + (d[2] + d[3]));
            const float rstd = rsqrtf(t * (1.f / 1024.f) + EPS);
#pragma unroll
            for (int bj = 0; bj < 2; ++bj)
#pragma unroll
                for (int n = 0; n < 2; ++n) __builtin_nontemporal_store(acc[ai][bj][m][n] * rstd * fw[bj][n], (f32x4*)(out + off + bj * HALF + 4 * n)); }
    }
};
}

namespace att {
constexpr int D = 128, LD = DM, NW = 8, QBLK = 32, KVBLK = 64, QB = NW * QBLK;
constexpr int SHM_V = KVBLK * D * 2, SHM_K = KVBLK * D * 2;
constexpr int F_OFF = 2 * SHM_V + 2 * SHM_K + NW * 64 * 4;
constexpr int ATT_LDS = F_OFF + 512;
constexpr float SCALE = 0.08838834764831845f;
constexpr float C2 = LOG2E * SCALE;
constexpr float THR2 = 12.f * LOG2E;
#define KSWZ(row, colB) ((row) * 256 + ((colB) ^ (((row) & 7) << 4)))
#define SBAR() __builtin_amdgcn_sched_barrier(0)
__device__ __forceinline__ int v_st(int k, int c) { const int kk = (k & ~0xC) | ((k & 4) << 1) | ((k & 8) >> 1); return ((kk >> 3) * 4 + (c >> 5)) * 512 + ((kk & 7) * 32 + (c & 31)) * 2; }
__device__ __forceinline__ int v_rd_base(int lane) { return ((lane & 3) << 3) | (((lane >> 2) & 3) << 6) | (((lane >> 4) & 1) << 5) | (((lane >> 5) & 1) << 8); }
constexpr int v_rd_off(int d0, int ks, int half) { return d0 * 512 + ks * 4096 + half * 2048; }
__device__ __forceinline__ int crow(int r, int hi) { return (r & 3) + 8 * (r >> 2) + 4 * hi; }
__device__ __forceinline__ bf16x8 load8(const bf16_t* p) { return *reinterpret_cast<const bf16x8*>(p); }
__device__ __forceinline__ void mask_tile(f32x16& p0, f32x16& p1, int dq) {
    const float NEG = -__builtin_inff();
#pragma unroll
    for (int r = 0; r < 16; ++r) {
        const int c = (r & 3) + 8 * (r >> 2);
        if (dq - c < 0) p0[r] = NEG;
        if (dq - c - 32 < 0) p1[r] = NEG;
    }
}
typedef float f32x8 __attribute__((ext_vector_type(8)));
__device__ __forceinline__ void partialSM(f32x16& p0, f32x16& p1, float& m_reg, float& mn, float& alpha, const char* fl) {
    { const f32x4 a = *(const f32x4*)(fl), b = *(const f32x4*)(fl + 32), c = *(const f32x4*)(fl + 64), d = *(const f32x4*)(fl + 96);
      const f32x16 fb = {a[0], a[1], a[2], a[3], b[0], b[1], b[2], b[3], c[0], c[1], c[2], c[3], d[0], d[1], d[2], d[3]};
      p0 = p0 * C2 + fb; }
    { const f32x4 a = *(const f32x4*)(fl + 128), b = *(const f32x4*)(fl + 160), c = *(const f32x4*)(fl + 192), d = *(const f32x4*)(fl + 224);
      const f32x16 fb = {a[0], a[1], a[2], a[3], b[0], b[1], b[2], b[3], c[0], c[1], c[2], c[3], d[0], d[1], d[2], d[3]};
      p1 = p1 * C2 + fb; }
    float pmax = p0[0];
#pragma unroll
    for (int r = 1; r < 16; ++r) pmax = fmaxf(pmax, p0[r]);
#pragma unroll
    for (int r = 0; r < 16; ++r) pmax = fmaxf(pmax, p1[r]);
    { auto rr = __builtin_amdgcn_permlane32_swap(__float_as_uint(pmax), __float_as_uint(pmax), false, false);
      pmax = fmaxf(__uint_as_float(rr[0]), __uint_as_float(rr[1])); }
    if (__builtin_expect(__all((pmax - m_reg) <= THR2), 1)) { mn = m_reg; alpha = 1.f; }
    else { mn = fmaxf(m_reg, pmax); alpha = __builtin_amdgcn_exp2f(m_reg - mn); m_reg = mn; }
    p0 = p0 - mn; p1 = p1 - mn;
#pragma unroll
    for (int r = 0; r < 16; ++r) p0[r] = __builtin_amdgcn_exp2f(p0[r]);
}
__device__ __forceinline__ void finishSM(f32x16& p0, f32x16& p1, float alpha, float& l_reg, bf16x8& pa0, bf16x8& pa1, bf16x8& pa2, bf16x8& pa3) {
#pragma unroll
    for (int r = 0; r < 16; ++r) p1[r] = __builtin_amdgcn_exp2f(p1[r]);
    float ps;
    { const f32x16 s16 = p0 + p1; const f32x8 s8 = s16.lo + s16.hi; const f32x4 s4 = s8.lo + s8.hi; const f32x2 s2 = s4.lo + s4.hi; ps = s2.x + s2.y; }
    { auto rr = __builtin_amdgcn_permlane32_swap(__float_as_uint(ps), __float_as_uint(ps), false, false);
      ps = __uint_as_float(rr[0]) + __uint_as_float(rr[1]); }
    l_reg = l_reg * alpha + ps;
#define PK4(P, B_, OUT) do { unsigned a0 = cvt_pk_bf16(P[B_+0], P[B_+1]), a1 = cvt_pk_bf16(P[B_+2], P[B_+3]);                          \
        unsigned b0 = cvt_pk_bf16(P[B_+4], P[B_+5]), b1 = cvt_pk_bf16(P[B_+6], P[B_+7]);                                             \
        auto r0 = __builtin_amdgcn_permlane32_swap(a0, b0, false, false); auto r1 = __builtin_amdgcn_permlane32_swap(a1, b1, false, false); \
        u32x4 w = {r0[0], r1[0], r0[1], r1[1]}; OUT = *reinterpret_cast<bf16x8*>(&w); } while (0)
    PK4(p0, 0, pa0); PK4(p0, 8, pa1); PK4(p1, 0, pa2); PK4(p1, 8, pa3);
#undef PK4
}
template <int KB>
__device__ __forceinline__ void qkt(f32x16& p0, f32x16& p1, const char* K_lds, int r32, int hi, const bf16x8* qr) {
    p0 = f32x16{}; p1 = f32x16{};
    const char* kb[4];
#pragma unroll
    for (int dd = 0; dd < 4; ++dd) kb[dd] = K_lds + KB * SHM_K + KSWZ(r32, (dd * 16 + hi * 8) * 2);
#pragma unroll
    for (int d0 = 0; d0 < 8; ++d0) { const char* a = kb[d0 & 3] + (d0 >> 2) * 128;
        bf16x8 b0 = *reinterpret_cast<const bf16x8*>(a);
        bf16x8 b1 = *reinterpret_cast<const bf16x8*>(a + 32 * 256);
        __builtin_amdgcn_s_setprio(1);
        p0 = __builtin_amdgcn_mfma_f32_32x32x16_bf16(b0, qr[d0], p0, 0, 0, 0);
        p1 = __builtin_amdgcn_mfma_f32_32x32x16_bf16(b1, qr[d0], p1, 0, 0, 0);
        __builtin_amdgcn_s_setprio(0); }
}
template <int VB>
__device__ __forceinline__ void pv_tile(f32x16* o, int vb0, bf16x8 pa0, bf16x8 pa1, bf16x8 pa2, bf16x8 pa3) {
#define TRRD(dst, off) asm volatile("ds_read_b64_tr_b16 %0, %1 offset:%2" : "=&v"(dst) : "v"(vb0), "i"(off) : "memory")
#define PV_D0(d0) do { s16x4 l0, l1, l2, l3, h0, h1, h2, h3; constexpr int b_ = VB * SHM_V + v_rd_off(d0, 0, 0); \
        TRRD(l0, b_); TRRD(h0, b_ + 2048); TRRD(l1, b_ + 4096); TRRD(h1, b_ + 6144); TRRD(l2, b_ + 8192); TRRD(h2, b_ + 10240); TRRD(l3, b_ + 12288); TRRD(h3, b_ + 14336); \
        asm volatile("s_waitcnt lgkmcnt(0)" ::: "memory"); SBAR(); __builtin_amdgcn_s_setprio(1);  \
        o[d0] = __builtin_amdgcn_mfma_f32_32x32x16_bf16(pa0, (bf16x8){l0[0], l0[1], l0[2], l0[3], h0[0], h0[1], h0[2], h0[3]}, o[d0], 0, 0, 0);   \
        o[d0] = __builtin_amdgcn_mfma_f32_32x32x16_bf16(pa1, (bf16x8){l1[0], l1[1], l1[2], l1[3], h1[0], h1[1], h1[2], h1[3]}, o[d0], 0, 0, 0);   \
        o[d0] = __builtin_amdgcn_mfma_f32_32x32x16_bf16(pa2, (bf16x8){l2[0], l2[1], l2[2], l2[3], h2[0], h2[1], h2[2], h2[3]}, o[d0], 0, 0, 0);   \
        o[d0] = __builtin_amdgcn_mfma_f32_32x32x16_bf16(pa3, (bf16x8){l3[0], l3[1], l3[2], l3[3], h3[0], h3[1], h3[2], h3[3]}, o[d0], 0, 0, 0); __builtin_amdgcn_s_setprio(0); } while (0)
    PV_D0(0); PV_D0(1); PV_D0(2); PV_D0(3);
#undef PV_D0
#undef TRRD
}
struct BlockRef { const bf16_t* Q; const bf16_t* K; const bf16_t* V; bf16_t* O; const float* F; float fref; int P0; int jlo; };
struct Seam { bf16x8 qr[8]; bf16x8 st_v0, st_v1, st_k0, st_k1; float st_f; };
#define ROW(p, k0, rr) ((p) + (size_t)((k0) + (rr)) * LD + sc)
#define VMW() asm volatile("s_waitcnt vmcnt(0)" ::: "memory")
#define VMWN(n) asm volatile("s_waitcnt vmcnt(%0)" :: "i"(n) : "memory")
#define SLOAD_H(Kp, Vp, Fp, k0) do { S.st_v0 = load8(ROW(Vp, k0, sr)); S.st_v1 = load8(ROW(Vp, k0, 32 + sr));              \
                         S.st_k0 = load8(ROW(Kp, k0, sr)); S.st_k1 = load8(ROW(Kp, k0, 32 + sr)); S.st_f = (Fp)[(k0) + (tid & 63)]; } while (0)
#define SWRITE_HK(bf, fr_) do { *(bf16x8*)(K_lds + (bf) * SHM_K + kws) = S.st_k0; *(bf16x8*)(K_lds + (bf) * SHM_K + kws + 32 * 256) = S.st_k1; \
                         if (tid < 64) *(float*)(F_lds + (bf) * 256 + tid * 4) = (fr_) - S.st_f; } while (0)
#define SWRITE_HV(bf) do { *(bf16x8*)(V_lds + (bf) * SHM_V + vst0) = S.st_v0; *(bf16x8*)(V_lds + (bf) * SHM_V + vst1) = S.st_v1; } while (0)
#define SWRITE_H(bf, fr_) do { SWRITE_HV(bf); SWRITE_HK(bf, fr_); } while (0)
__device__ __forceinline__ void attn_prime(const BlockRef& cur, char* lds, Seam& S, const int wid) {
    const int lane = fresh_lane(), tid = wid * 64 + lane, r32 = lane & 31, hi = lane >> 5;
    const int sr = tid >> 4, sc = (tid & 15) * 8, kws = KSWZ(sr, sc * 2); char* K_lds = lds + 2 * SHM_V; char* F_lds = lds + F_OFF;
#pragma unroll
    for (int d0 = 0; d0 < 8; ++d0) S.qr[d0] = load8(cur.Q + (size_t)(wid * QBLK + r32) * LD + d0 * 16 + hi * 8);
    SLOAD_H(cur.K, cur.V, cur.F, cur.jlo * KVBLK); VMW(); SWRITE_HK(0, cur.fref);
    __syncthreads();
}
__device__ __forceinline__ void attn_block(const BlockRef& cur, const BlockRef& nxt, char* lds, Seam& S, const int wid) {
    const int lane = fresh_lane(), tid = wid * 64 + lane; const int r32 = lane & 31, hi = lane >> 5;
    const int j_lo = cur.jlo;
    const int NT = (cur.P0 + QB - 1) / KVBLK + 1 - j_lo;
    const int kbn = nxt.jlo * KVBLK;
    const int qlo = cur.P0 + wid * QBLK, qm = qlo + r32 - 4 * hi;
    char* V_lds = lds; char* K_lds = lds + 2 * SHM_V; char* F_lds = lds + F_OFF;
    float* ws = (float*)(lds + 2 * SHM_V + 2 * SHM_K) + wid * 64; float* li_l = ws, * al_l = ws + 32;
    float m_reg = -1e30f, l_reg = 0; f32x16 o[4] = {};
    const int sr = tid >> 4, sc = (tid & 15) * 8, vst0 = v_st(sr, sc), vst1 = v_st(32 + sr, sc), kws = KSWZ(sr, sc * 2);
    const int vb0 = (int)(uintptr_t)V_lds + v_rd_base(lane);
    const char* flr = F_lds + 16 * hi;
    const bf16_t* Kh = cur.K; const bf16_t* Vh = cur.V; const float* Fh = cur.F; const float fref = cur.fref;
#define RESC(a) do { if (__any((a) < 1.f)) { if (hi == 0) al_l[r32] = (a); asm volatile("s_waitcnt lgkmcnt(0)" ::: "memory");              \
                     for (int d_ = 0; d_ < 4; ++d_) for (int r = 0; r < 16; ++r) o[d_][r] *= al_l[crow(r, hi)]; } } while (0)
#define KBASE(t) ((j_lo + (t)) * KVBLK)
#define MASKT(P0_, P1_, t) do { const int kb_ = KBASE(t); if (kb_ + KVBLK - 1 > qlo) mask_tile(P0_, P1_, qm - kb_); } while (0)
#define SEAM_K0() do { VMWN(8); SWRITE_HK(0, nxt.fref); SBAR(); } while (0)
    f32x16 pA0, pA1, pB0, pB1; float mnA, mnB, alA, alB; bf16x8 pa0, pa1, pa2, pa3;
    SWRITE_HV(0); SBAR();
    if (NT > 1) { SLOAD_H(Kh, Vh, Fh, KBASE(1)); }
    SBAR(); qkt<0>(pA0, pA1, K_lds, r32, hi, S.qr);
    MASKT(pA0, pA1, 0); partialSM(pA0, pA1, m_reg, mnA, alA, flr);
    if (NT > 1) { VMW(); SWRITE_H(1, fref); }
    __syncthreads();
#define HALF_STEP(PX0, PX1, mnX, alX, PY0, PY1, alY, t, KB, VB, SB) do {                                                      \
        SBAR(); qkt<KB>(PX0, PX1, K_lds, r32, hi, S.qr);                                             \
        finishSM(PY0, PY1, alY, l_reg, pa0, pa1, pa2, pa3); SBAR();                                                           \
        if ((t) + 1 < NT) { SLOAD_H(Kh, Vh, Fh, KBASE((t) + 1)); SBAR(); }                                               \
        pv_tile<VB>(o, vb0, pa0, pa1, pa2, pa3); MASKT(PX0, PX1, (t)); partialSM(PX0, PX1, m_reg, mnX, alX, flr + (KB) * 256);       \
        __syncthreads();                                                                                                      \
        if ((t) + 1 < NT) { VMW(); SWRITE_H(SB, fref); }                                                                          \
        RESC(alX); __syncthreads(); } while (0)
    for (int t = 1; t + 1 < NT; t += 2) {
        HALF_STEP(pB0, pB1, mnB, alB, pA0, pA1, alA, t, 1, 0, 0);
        HALF_STEP(pA0, pA1, mnA, alA, pB0, pB1, alB, t + 1, 0, 1, 1);
    }
    const bool even = (NT & 1) == 0;
    if (even) { SBAR(); qkt<1>(pB0, pB1, K_lds, r32, hi, S.qr); SBAR(); }
    SLOAD_H(nxt.K, nxt.V, nxt.F, kbn); SBAR();
#pragma unroll
    for (int d0 = 0; d0 < 8; ++d0) S.qr[d0] = load8(nxt.Q + (size_t)(wid * QBLK + r32) * LD + d0 * 16 + hi * 8);
    SBAR();
    finishSM(pA0, pA1, alA, l_reg, pa0, pa1, pa2, pa3); SBAR();
    pv_tile<0>(o, vb0, pa0, pa1, pa2, pa3);
    if (even) { MASKT(pB0, pB1, NT - 1); partialSM(pB0, pB1, m_reg, mnB, alB, flr + 256); __syncthreads(); RESC(alB);
        finishSM(pB0, pB1, alB, l_reg, pa0, pa1, pa2, pa3); SBAR(); pv_tile<1>(o, vb0, pa0, pa1, pa2, pa3); }
    SBAR(); SEAM_K0();
    if (hi == 0) li_l[r32] = l_reg; asm volatile("s_waitcnt lgkmcnt(0)" ::: "memory");
    float rli[16];
#pragma unroll
    for (int r = 0; r < 16; ++r) rli[r] = __builtin_amdgcn_rcpf(li_l[crow(r, hi)]);
    bf16_t* Ow = cur.O + (size_t)(wid * QBLK) * LD;
#pragma unroll
    for (int hf = 0; hf < 2; ++hf) {
        float zz[16][2];
#pragma unroll
        for (int r = 0; r < 16; ++r)
#pragma unroll
            for (int dd = 0; dd < 2; ++dd) zz[r][dd] = bf2f(Ow[(size_t)crow(r, hi) * LD + (hf * 2 + dd) * 32 + r32]);
        asm volatile("" ::: "memory");
#pragma unroll
        for (int r = 0; r < 16; ++r)
#pragma unroll
            for (int dd = 0; dd < 2; ++dd) { const int d0 = hf * 2 + dd; bf16_t* op = Ow + (size_t)crow(r, hi) * LD + d0 * 32 + r32;
                const float v = o[d0][r] * rli[r] * siluf_(zz[r][dd]);
                const float vn = __builtin_bit_cast(float, __builtin_amdgcn_update_dpp(0, __builtin_bit_cast(int, v), 0xB1, 0xf, 0xf, true));
                if ((r32 & 1) == 0) *(unsigned*)op = cvt_pk_bf16(v, vn); }
        asm volatile("" ::: "memory");
    }
    __syncthreads();
#undef RESC
#undef KBASE
#undef MASKT
#undef SEAM_K0
#undef HALF_STEP
}
#undef ROW
#undef VMW
#undef VMWN
#undef SLOAD_H
#undef SWRITE_HK
#undef SWRITE_HV
#undef SWRITE_H
#undef KSWZ
}

__device__ __forceinline__ void transpose_item(const float* W, int ldw, int srccol0, bf16_t* WT, int dstrow0, int k0, const float* kscale, LAS float* scr, int lane) {
#pragma unroll 8
    for (int i = 0; i < 32; ++i) { const int kk = 2 * i + (lane >> 5); float v = W[(size_t)(k0 + kk) * ldw + srccol0 + (lane & 31)]; if (kscale) v *= kscale[k0 + kk]; scr[kk * 33 + (lane & 31)] = v; }
    LDS_WAIT(); asm volatile("" ::: "memory");
    const int c = lane & 7;
#pragma unroll
    for (int j = 0; j < 4; ++j) { const int n = (lane >> 3) + 8 * j; const LAS float* s = scr + (8 * c) * 33 + n;
        u32x4 o; o.x = cvt_pk_bf16(s[0 * 33], s[1 * 33]); o.y = cvt_pk_bf16(s[2 * 33], s[3 * 33]); o.z = cvt_pk_bf16(s[4 * 33], s[5 * 33]); o.w = cvt_pk_bf16(s[6 * 33], s[7 * 33]);
        *(u32x4*)(WT + (size_t)(dstrow0 + n) * 1024 + k0 + 8 * c) = o; }
    LDS_WAIT(); asm volatile("" ::: "memory");
}

__device__ __forceinline__ void phase0(const Params& p, unsigned char* lds, int tid, int lane, int wave) {
    float* ada = (float*)(p.ws + WS_ADA);
    float* red = (float*)(lds + 131072);
    const int G = gridDim.x;
    for (int it = blockIdx.x; it < 256; it += G) {
        const int col0 = it * 12;
        float acc[4][12];
#pragma unroll
        for (int b = 0; b < 4; ++b)
#pragma unroll
            for (int j = 0; j < 12; ++j) acc[b][j] = 0.f;
#pragma unroll
        for (int rr = 0; rr < 2; ++rr) {
            const int row = wave * 128 + rr * 64 + lane;
            const f32x4* wp = (const f32x4*)(p.w_ada + (size_t)row * 3072 + col0);
            const f32x4 w0 = wp[0], w1 = wp[1], w2 = wp[2];
#pragma unroll
            for (int b = 0; b < 4; ++b) { const float s = siluf_(p.c[b * 1024 + row]);
#pragma unroll
                for (int j = 0; j < 4; ++j) { acc[b][j] += s * w0[j]; acc[b][4 + j] += s * w1[j]; acc[b][8 + j] += s * w2[j]; } }
        }
#pragma unroll
        for (int b = 0; b < 4; ++b)
#pragma unroll
            for (int j = 0; j < 12; ++j) { const float s = wave_sum(acc[b][j]); if (lane == 0) red[wave * 48 + b * 12 + j] = s; }
        __syncthreads();
        if (tid < 48) { float s = 0.f;
#pragma unroll
            for (int w = 0; w < 8; ++w) s += red[w * 48 + tid];
            const int b = tid / 12, j = tid % 12; ada[b * 3072 + col0 + j] = s + p.b_ada[col0 + j]; }
        __syncthreads();
    }
    if (blockIdx.x == 1 && tid < 128) ((unsigned*)(p.ws + WS_PCNT))[64 * tid] = 0u;
    if (blockIdx.x == 2) { for (int i = tid; i < 2048; i += NTHREADS) ((unsigned*)(p.ws + WS_QBD))[i] = (i & 1) ? 0x7fffffffu : 0u; }
    if (blockIdx.x == 0 && tid < 65) { if (tid < 64) ((unsigned*)(p.ws + WS_NORM2))[tid] = 0u; else { *(unsigned*)(p.ws + WS_QCTR) = 0u; ((unsigned*)(p.ws + WS_QCTR))[64] = 0u; } }
    { float* wsm = (float*)(p.ws + WS_WSMALL);
      for (int i = blockIdx.x * NTHREADS + tid; i < 24 * 1024; i += G * NTHREADS) { const int cc = i >> 10, k = i & 1023; const int src = cc < 16 ? 2304 + cc : 6416 + (cc - 16);
          wsm[i] = p.w_in[(size_t)k * IN_COLS + src]; } }
    LAS float* scr = (LAS float*)((LAS unsigned char*)lds + wave * 16384);
    const int gw = blockIdx.x * 8 + wave, NGW = G * 8;
    constexpr int I_IN = 264 * 16, I_P = 32 * 16;
    for (int it = gw; it < I_IN + 3 * I_P; it += NGW) {
        int r = it;
        if (r < I_IN) { const int nb = r >> 4, kb = r & 15; const int d0 = nb * 32; const int s0 = d0 < 2304 ? d0 : (d0 < 6400 ? d0 + 16 : d0 + 24);
            transpose_item(p.w_in, IN_COLS, s0, (bf16_t*)(p.ws + WS_WIN), d0, kb * 64, nullptr, scr, lane); continue; }
        r -= I_IN;
        if (r < I_P) { transpose_item(p.w_proj_ssm, 1024, (r >> 4) * 32, (bf16_t*)(p.ws + WS_WP), (r >> 4) * 32, (r & 15) * 64, p.ssm_norm_w, scr, lane); continue; }
        r -= I_P;
        if (r < I_P) { transpose_item(p.w_proj_att, 1024, (r >> 4) * 32, (bf16_t*)(p.ws + WS_WP), 1024 + (r >> 4) * 32, (r & 15) * 64, nullptr, scr, lane); continue; }
        r -= I_P;
        transpose_item(p.w_out, 1024, (r >> 4) * 32, (bf16_t*)(p.ws + WS_WOUT), (r >> 4) * 32, (r & 15) * 64, nullptr, scr, lane);
    }
}

constexpr int WPITCH = 1032;
__device__ __forceinline__ void phase1(const Params& p, unsigned char* lds, int tid, int lane, int wave) {
    const float* ada = (const float*)(p.ws + WS_ADA);
    const float* wsm = (const float*)(p.ws + WS_WSMALL);
    bf16_t* Whi = (bf16_t*)lds; bf16_t* Wlo = Whi + 24 * WPITCH;
    float* g1s = (float*)(lds + 2 * 24 * WPITCH * 2); float* shs = g1s + 1024;
    float* red = shs + 1024;
    f32x4* accp = (f32x4*)(red + 256);
    for (int i = tid; i < 24 * 1024; i += NTHREADS) { const float w = wsm[i]; const bf16_t hi = f2bf(w); const int c = i >> 10, k = i & 1023;
        Whi[c * WPITCH + k] = hi; Wlo[c * WPITCH + k] = f2bf(w - bf2f(hi)); }
    bf16_t* H = (bf16_t*)((unsigned char*)p.out + OUT_H);
    float* DT = (float*)(p.ws + WS_DT); float* LF = (float*)(p.ws + WS_LOGF);
    const int fr = lane & 15, fq = lane >> 4;
    const int c1 = (16 + fr) < 24 ? (16 + fr) : 23;
    const int kw = 128 * wave + 8 * fq;
    for (int base = blockIdx.x * 8; base < M / 16; base += gridDim.x * 8) {
        const int b = (base * 16) >> 13;
        __syncthreads();
        for (int i = tid; i < 1024; i += NTHREADS) { g1s[i] = p.norm_w[i] * (1.f + ada[b * 3072 + 1024 + i]); shs[i] = ada[b * 3072 + i]; }
        __syncthreads();
        f32x4 xa[4], xc[4];
        { const float* xr = p.x + (size_t)(base * 16 + fr) * DM + kw;
#pragma unroll
          for (int kk = 0; kk < 4; ++kk) { xa[kk] = __builtin_nontemporal_load((const f32x4*)(xr + 32 * kk)); xc[kk] = __builtin_nontemporal_load((const f32x4*)(xr + 32 * kk + 4)); } }
        for (int gi = 0; gi < 8; ++gi) {
            const int row0 = (base + gi) * 16, par = gi & 1;
            f32x4 na[4], nc[4];
            { const int gn = gi < 7 ? gi + 1 : 7; const float* xr = p.x + (size_t)((base + gn) * 16 + fr) * DM + kw;
#pragma unroll
              for (int kk = 0; kk < 4; ++kk) { na[kk] = __builtin_nontemporal_load((const f32x4*)(xr + 32 * kk)); nc[kk] = __builtin_nontemporal_load((const f32x4*)(xr + 32 * kk + 4)); } }
            float ss = 0.f;
#pragma unroll
            for (int kk = 0; kk < 4; ++kk) { const f32x4 a = xa[kk], c = xc[kk];
                ss += ((a[0] * a[0] + a[1] * a[1]) + (a[2] * a[2] + a[3] * a[3])) + ((c[0] * c[0] + c[1] * c[1]) + (c[2] * c[2] + c[3] * c[3])); }
            ss += __shfl_xor(ss, 16); ss += __shfl_xor(ss, 32);
            if (fq == 0) red[par * 128 + wave * 16 + fr] = ss;
            __syncthreads();
            float tot = 0.f;
#pragma unroll
            for (int w = 0; w < 8; ++w) tot += red[par * 128 + w * 16 + fr];
            const float rstd = rsqrtf(tot * (1.f / DM) + EPS);
            f32x4 acc0 = {0.f, 0.f, 0.f, 0.f}, acc1 = {0.f, 0.f, 0.f, 0.f};
            bf16_t* hr = H + (size_t)(row0 + fr) * DM + kw;
#pragma unroll
            for (int kk = 0; kk < 4; ++kk) {
                const int k = kw + 32 * kk;
                const f32x4 ga = *(const f32x4*)(g1s + k), gc = *(const f32x4*)(g1s + k + 4), sa = *(const f32x4*)(shs + k), sc = *(const f32x4*)(shs + k + 4);
                const f32x4 ha = xa[kk] * rstd * ga + sa, hc = xc[kk] * rstd * gc + sc;
                u32x4 hw; hw.x = cvt_pk_bf16(ha[0], ha[1]); hw.y = cvt_pk_bf16(ha[2], ha[3]); hw.z = cvt_pk_bf16(hc[0], hc[1]); hw.w = cvt_pk_bf16(hc[2], hc[3]);
                *(u32x4*)(hr + 32 * kk) = hw;
                u32x4 lw; lw.x = cvt_pk_bf16(ha[0] - bflo(hw.x), ha[1] - bfhi(hw.x)); lw.y = cvt_pk_bf16(ha[2] - bflo(hw.y), ha[3] - bfhi(hw.y));
                lw.z = cvt_pk_bf16(hc[0] - bflo(hw.z), hc[1] - bfhi(hw.z)); lw.w = cvt_pk_bf16(hc[2] - bflo(hw.w), hc[3] - bfhi(hw.w));
                const bf16x8 ahi = __builtin_bit_cast(bf16x8, hw), alo = __builtin_bit_cast(bf16x8, lw);
                const bf16x8 bh0 = *(const bf16x8*)(Whi + fr * WPITCH + k), bl0 = *(const bf16x8*)(Wlo + fr * WPITCH + k);
                const bf16x8 bh1 = *(const bf16x8*)(Whi + c1 * WPITCH + k), bl1 = *(const bf16x8*)(Wlo + c1 * WPITCH + k);
                acc0 = __builtin_amdgcn_mfma_f32_16x16x32_bf16(ahi, bh0, acc0, 0, 0, 0); acc0 = __builtin_amdgcn_mfma_f32_16x16x32_bf16(alo, bh0, acc0, 0, 0, 0); acc0 = __builtin_amdgcn_mfma_f32_16x16x32_bf16(ahi, bl0, acc0, 0, 0, 0);
                acc1 = __builtin_amdgcn_mfma_f32_16x16x32_bf16(ahi, bh1, acc1, 0, 0, 0); acc1 = __builtin_amdgcn_mfma_f32_16x16x32_bf16(alo, bh1, acc1, 0, 0, 0); acc1 = __builtin_amdgcn_mfma_f32_16x16x32_bf16(ahi, bl1, acc1, 0, 0, 0);
            }
            accp[((par * 8 + wave) * 2 + 0) * 64 + lane] = acc0; accp[((par * 8 + wave) * 2 + 1) * 64 + lane] = acc1;
            __syncthreads();
            if (wave < 2) {
                f32x4 t = accp[((par * 8 + 0) * 2 + wave) * 64 + lane];
#pragma unroll
                for (int w = 1; w < 8; ++w) t = t + accp[((par * 8 + w) * 2 + wave) * 64 + lane];
                if (wave == 0) { const float bdt = p.dt_bias[fr];
#pragma unroll
                    for (int j = 0; j < 4; ++j) { const float u = t[j] + bdt; DT[(size_t)(row0 + 4 * fq + j) * 16 + fr] = u > 20.f ? u : log1pf(__expf(u)); } }
                else if (fr < 8) { const float bff = p.b_f[fr];
#pragma unroll
                    for (int j = 0; j < 4; ++j) { const float u = t[j] + bff; LF[(size_t)(row0 + 4 * fq + j) * 8 + fr] = u < -20.f ? u : -log1pf(__expf(-u)); } }
            }
#pragma unroll
            for (int kk = 0; kk < 4; ++kk) { xa[kk] = na[kk]; xc[kk] = nc[kk]; }
        }
    }
    __syncthreads();
}

__device__ __forceinline__ void phase_fcum(const Params& p, unsigned char* lds, int tid, int lane, int wave) {
    const float* LF = (const float*)(p.ws + WS_LOGF); float* FL = (float*)(p.ws + WS_FL);
    float* wt = (float*)(lds + 131072);
    for (int s = (int)blockIdx.x - (gridDim.x >= 64 ? (int)gridDim.x / 2 : 0); s >= 0 && s < 32; s += gridDim.x) {
        const int b = s >> 3, h = s & 7; const int t0 = tid * 16;
        float v[16]; float run = 0.f;
#pragma unroll
        for (int i = 0; i < 16; ++i) { run += LF[((size_t)b * SEQ + t0 + i) * 8 + h]; v[i] = run; }
        float inc = run;
#pragma unroll
        for (int o = 1; o < 64; o <<= 1) { const float t = __shfl_up(inc, o); if (lane >= o) inc += t; }
        if (lane == 63) wt[wave] = inc;
        __syncthreads();
        float off = inc - run;
        for (int w = 0; w < wave; ++w) off += wt[w];
#pragma unroll
        for (int i = 0; i < 16; ++i) FL[(size_t)s * SEQ + t0 + i] = (v[i] + off) * LOG2E;
        __syncthreads();
    }
}

__device__ __forceinline__ void conv8_load(const bf16_t* xb, int tbase, int l0, int ch, bf16_t (&raw)[11]) {
#pragma unroll
    for (int i = 0; i < 11; ++i) { const int t = tbase + l0 - 3 + i; raw[i] = xb[(size_t)(t < 0 ? 0 : t) * XPITCH + ch]; }
}
__device__ __forceinline__ void conv8_fin(const bf16_t (&raw)[11], int tbase, int l0, int ch, const float* cw, const float* cb, float (&out)[8]) {
    const float w0 = cw[ch], w1 = cw[CONVD + ch], w2 = cw[2 * CONVD + ch], w3 = cw[3 * CONVD + ch], bb = cb[ch];
    float u[11];
#pragma unroll
    for (int i = 0; i < 11; ++i) { const int t = tbase + l0 - 3 + i; u[i] = (t >= 0) ? bf2f(raw[i]) : 0.f; }
#pragma unroll
    for (int i = 0; i < 8; ++i) { const float v = bb + w0 * u[i] + w1 * u[i + 1] + w2 * u[i + 2] + w3 * u[i + 3]; out[i] = siluf_(v); }
}
__device__ __forceinline__ void conv8(const bf16_t* xb, int tbase, int l0, int ch, const float* cw, const float* cb, float (&out)[8]) {
    bf16_t raw[11]; conv8_load(xb, tbase, l0, ch, raw); conv8_fin(raw, tbase, l0, ch, cw, cb, out);
}
__device__ __forceinline__ float wave_chunk_scan(const float* DT, size_t row0, int hd, float expA, float* w_acs, float* w_dt, int lane) {
    const float d0 = DT[(row0 + 2 * lane) * 16 + hd], d1 = DT[(row0 + 2 * lane + 1) * 16 + hd];
    const float a0 = -d0 * expA, a1 = -d1 * expA; float inc = a0 + a1;
#pragma unroll
    for (int o = 1; o < 64; o <<= 1) { const float t = __shfl_up(inc, o); if (lane >= o) inc += t; }
    *(f32x2*)(w_acs + 2 * lane) = (f32x2){inc - a1, inc}; *(f32x2*)(w_dt + 2 * lane) = (f32x2){d0, d1};
    return __shfl(inc, 63);
}
__device__ __forceinline__ bf16x8 pack8f(const float (&o)[8]) {
    u32x4 w; w.x = cvt_pk_bf16(o[0], o[1]); w.y = cvt_pk_bf16(o[2], o[3]); w.z = cvt_pk_bf16(o[4], o[5]); w.w = cvt_pk_bf16(o[6], o[7]);
    return __builtin_bit_cast(bf16x8, w);
}
constexpr int LT = 136;
constexpr int LN = 72;

__device__ __forceinline__ void phase_ssd_a(const Params& p, unsigned char* lds, int tid, int lane, int wave) {
    const bf16_t* P = (const bf16_t*)(p.ws + WS_P); const float* DT = (const float*)(p.ws + WS_DT);
    float* ST = (float*)((unsigned char*)p.out + OUT_ST); float* ACH = (float*)(p.ws + WS_ACH);
    float* w_acs = (float*)lds + wave * 256; float* w_dt = w_acs + 128;
    float* cwl = (float*)lds + 8 * 256;
    { float tw[13];
#pragma unroll
      for (int j = 0; j < 13; ++j) { const int i = tid + j * NTHREADS; tw[j] = i < 4 * CONVD ? p.conv_w[i] : (i < 5 * CONVD ? p.conv_b[i - 4 * CONVD] : 0.f); }
      asm volatile("" ::: "memory");
#pragma unroll
      for (int j = 0; j < 13; ++j) { const int i = tid + j * NTHREADS; if (i < 5 * CONVD) cwl[i] = tw[j]; } }
    __syncthreads();
    const int qk_ch = blockIdx.x * 8 + wave; int qk_row = 0; float mq0 = 0.f, mq1 = 0.f, mk0 = 0.f, mk1 = 0.f, dn0 = 3.0e38f, dn1 = 3.0e38f;
#define QK_LOAD() const bf16_t* rp_ = P + (size_t)(qk_ch * 16 + (qk_row < 15 ? qk_row : 15)) * DM + 8 * lane; \
        const u32x4 qa_ = *(const u32x4*)(rp_ + SEG_Q), qb_ = *(const u32x4*)(rp_ + SEG_Q + 512), qc_ = *(const u32x4*)(rp_ + SEG_K), qd_ = *(const u32x4*)(rp_ + SEG_K + 512)
#define QK_SQ8(V_) ((bflo(V_.x) * bflo(V_.x) + bfhi(V_.x) * bfhi(V_.x)) + (bflo(V_.y) * bflo(V_.y) + bfhi(V_.y) * bfhi(V_.y)) + (bflo(V_.z) * bflo(V_.z) + bfhi(V_.z) * bfhi(V_.z)) + (bflo(V_.w) * bflo(V_.w) + bfhi(V_.w) * bfhi(V_.w)))
#define QK_DOT8(A_, B_) ((bflo(A_.x) * bflo(B_.x) + bfhi(A_.x) * bfhi(B_.x)) + (bflo(A_.y) * bflo(B_.y) + bfhi(A_.y) * bfhi(B_.y)) + (bflo(A_.z) * bflo(B_.z) + bfhi(A_.z) * bfhi(B_.z)) + (bflo(A_.w) * bflo(B_.w) + bfhi(A_.w) * bfhi(B_.w)))
#define QK_ROWSUM(v) do { v += DPPF(v, 0xB1); v += DPPF(v, 0x4E); v += DPPF(v, 0x141); v += DPPF(v, 0x140); } while (0)
#define QK_FIN() do { float sa_ = QK_SQ8(qa_), sb_ = QK_SQ8(qb_), sc_ = QK_SQ8(qc_), sd_ = QK_SQ8(qd_); float da_ = QK_DOT8(qa_, qc_), db_ = QK_DOT8(qb_, qd_); QK_ROWSUM(sa_); QK_ROWSUM(sb_); QK_ROWSUM(sc_); QK_ROWSUM(sd_); QK_ROWSUM(da_); QK_ROWSUM(db_); \
        if (qk_row < 16 && qk_ch < M / 16) { mq0 = fmaxf(mq0, sa_); mq1 = fmaxf(mq1, sb_); mk0 = fmaxf(mk0, sc_); mk1 = fmaxf(mk1, sd_); dn0 = fminf(dn0, da_); dn1 = fminf(dn1, db_); } ++qk_row; } while (0)
    for (int it = blockIdx.x; it < NB * NCH * 2; it += gridDim.x) {
        asm volatile("" : "+v"(lane));
        const int fr = lane & 15, fq = lane >> 4;
        const int g = it & 1, c = (it >> 1) & 63, b = it >> 7, hd = g * 8 + wave;
        const size_t row0 = (size_t)b * SEQ + c * CHUNK;
        const bf16_t* xb = P + SEG_XBC + (size_t)b * SEQ * XPITCH;
        const float atot = wave_chunk_scan(DT, row0, hd, __expf(p.a_log[hd]), w_acs, w_dt, lane);
        f32x4 acc[4][4];
#pragma unroll
        for (int a = 0; a < 4; ++a)
#pragma unroll
            for (int q = 0; q < 4; ++q) acc[a][q] = (f32x4){0.f, 0.f, 0.f, 0.f};
#pragma unroll 1
        for (int kk = 0; kk < 4; ++kk) {
            int l0 = 32 * kk + 8 * fq; asm volatile("" : "+v"(l0));
            const f32x4 ac0 = *(const f32x4*)(w_acs + l0), ac1 = *(const f32x4*)(w_acs + l0 + 4), dd0 = *(const f32x4*)(w_dt + l0), dd1 = *(const f32x4*)(w_dt + l0 + 4);
            float wv[8];
#pragma unroll
            for (int i = 0; i < 4; ++i) { wv[i] = dd0[i] * __expf(atot - ac0[i]); wv[4 + i] = dd1[i] * __expf(atot - ac1[i]); }
            bf16x8 af[4], bfr[4];
            { bf16_t rawx[4][11];
#pragma unroll
              for (int pt = 0; pt < 4; ++pt) conv8_load(xb, c * CHUNK, l0, hd * 64 + 16 * pt + fr, rawx[pt]);
              QK_LOAD();
              asm volatile("" ::: "memory");
              QK_FIN();
#pragma unroll
              for (int pt = 0; pt < 4; ++pt) { float o[8]; conv8_fin(rawx[pt], c * CHUNK, l0, hd * 64 + 16 * pt + fr, cwl, cwl + 4 * CONVD, o);
#pragma unroll
                  for (int i = 0; i < 8; ++i) o[i] *= wv[i];
                  af[pt] = pack8f(o); } }
            { bf16_t rawb[4][11];
#pragma unroll
              for (int nt = 0; nt < 4; ++nt) conv8_load(xb, c * CHUNK, l0, 1024 + g * 64 + 16 * nt + fr, rawb[nt]);
              QK_LOAD();
              asm volatile("" ::: "memory");
              QK_FIN();
#pragma unroll
              for (int nt = 0; nt < 4; ++nt) { float o[8]; conv8_fin(rawb[nt], c * CHUNK, l0, 1024 + g * 64 + 16 * nt + fr, cwl, cwl + 4 * CONVD, o); bfr[nt] = pack8f(o); } }
#pragma unroll
            for (int pt = 0; pt < 4; ++pt)
#pragma unroll
                for (int nt = 0; nt < 4; ++nt) acc[pt][nt] = __builtin_amdgcn_mfma_f32_16x16x32_bf16(af[pt], bfr[nt], acc[pt][nt], 0, 0, 0);
        }
        const int ih = (b * NCH + c) * NHS + hd;
        float* so = ST + (size_t)ih * 4096;
#pragma unroll
        for (int pt = 0; pt < 4; ++pt)
#pragma unroll
            for (int nt = 0; nt < 4; ++nt)
#pragma unroll
                for (int j = 0; j < 4; ++j) __builtin_nontemporal_store(acc[pt][nt][j], so + (16 * pt + 4 * fq + j) * 64 + 16 * nt + fr);
        if (lane == 0) ACH[ih] = atot;
    }
    while (qk_row < 16) { QK_LOAD(); QK_FIN(); }
#undef QK_LOAD
#undef QK_SQ8
#undef QK_DOT8
#undef QK_ROWSUM
#undef QK_FIN
    { float* red = (float*)(lds + 131072); unsigned* N2 = (unsigned*)(p.ws + WS_NORM2);
      float* redd = red + 128;
      if ((lane & 15) == 0) { const int h0 = lane >> 4; float* r = red + wave * 16; r[h0] = mq0; r[4 + h0] = mq1; r[8 + h0] = mk0; r[12 + h0] = mk1; redd[wave * 8 + h0] = dn0; redd[wave * 8 + 4 + h0] = dn1; }
      __syncthreads();
      if (wave == 0 && lane < 16 && blockIdx.x * 8 < M / 16) { float v = red[lane];
#pragma unroll
          for (int w = 1; w < 8; ++w) v = fmaxf(v, red[w * 16 + lane]);
          const int row_b = blockIdx.x * 128, b = row_b >> 13, qb = (row_b & (SEQ - 1)) >> 8;
          atomicMax(N2 + (b * 8 + (lane & 7)) * 2 + (lane >> 3), __float_as_uint(v));
          if (lane < 8) { float d = redd[lane];
#pragma unroll
              for (int w = 1; w < 8; ++w) d = fminf(d, redd[w * 8 + lane]);
              unsigned* qbd = (unsigned*)(p.ws + WS_QBD) + ((b * 8 + lane) * 32 + qb) * 2;
              atomicMax(qbd, __float_as_uint(v)); atomicMin((int*)qbd + 1, fkey(d)); } }
      __syncthreads(); }
}
__device__ __forceinline__ void phase_ssd_scan(const Params& p, int tid) {
    float* ST = (float*)((unsigned char*)p.out + OUT_ST); const float* ACH = (const float*)(p.ws + WS_ACH);
    for (int e = blockIdx.x * NTHREADS + tid; e < NB * NHS * 4096; e += gridDim.x * NTHREADS) {
        const int pn = e & 4095, hd = (e >> 12) & 15, b = e >> 16;
        float run = 0.f;
        float* sp = ST + ((size_t)(b * NCH) * NHS + hd) * 4096 + pn;
        const float* ap = ACH + (b * NCH) * NHS + hd;
        for (int c0 = 0; c0 < NCH; c0 += 32) { float s[32], a[32];
#pragma unroll
            for (int i = 0; i < 32; ++i) { s[i] = __builtin_nontemporal_load(sp + (size_t)(c0 + i) * NHS * 4096); a[i] = ap[(c0 + i) * NHS]; }
#pragma unroll
            for (int i = 0; i < 32; ++i) { __builtin_nontemporal_store(run, sp + (size_t)(c0 + i) * NHS * 4096); run = __expf(a[i]) * run + s[i]; } }
    }
}
__device__ __forceinline__ void phase_ssd_c(const Params& p, unsigned char* lds, int tid, int lane, int wave) {
    bf16_t* P = (bf16_t*)(p.ws + WS_P); const float* DT = (const float*)(p.ws + WS_DT);
    const float* ST = (const float*)((unsigned char*)p.out + OUT_ST); float* SSQ = (float*)(p.ws + WS_SSQ);
    bf16_t* cN = (bf16_t*)lds;
    bf16_t* bN = cN + 128 * LN;
    bf16_t* cbL = bN + 128 * LN;
    float* w_acs = (float*)(cbL + 128 * LT) + wave * 256; float* w_dt = w_acs + 128;
    float* cwl = (float*)(lds + 98304);
    { float tw[13];
#pragma unroll
      for (int j = 0; j < 13; ++j) { const int i = tid + j * NTHREADS; tw[j] = i < 4 * CONVD ? p.conv_w[i] : (i < 5 * CONVD ? p.conv_b[i - 4 * CONVD] : 0.f); }
      asm volatile("" ::: "memory");
#pragma unroll
      for (int j = 0; j < 13; ++j) { const int i = tid + j * NTHREADS; if (i < 5 * CONVD) cwl[i] = tw[j]; } }
    __syncthreads();
    for (int it = blockIdx.x; it < NB * NCH * 2; it += gridDim.x) {
        asm volatile("" : "+v"(lane));
        const int fr = lane & 15, fq = lane >> 4;
        const int g = it & 1, c = (it >> 1) & 63, b = it >> 7, hd = g * 8 + wave;
        const size_t row0 = (size_t)b * SEQ + c * CHUNK;
        const bf16_t* xb = P + SEG_XBC + (size_t)b * SEQ * XPITCH;
        bf16_t rawc[4][11];
#pragma unroll
        for (int uu = 0; uu < 4; ++uu) { const int unit = wave + 8 * uu, tens = unit >> 4, l0 = (unit & 15) * 8; conv8_load(xb, c * CHUNK, l0, 1024 + tens * 128 + g * 64 + lane, rawc[uu]); }
        asm volatile("" ::: "memory");
#pragma unroll
        for (int uu = 0; uu < 4; ++uu) { const int unit = wave + 8 * uu, tens = unit >> 4, l0 = (unit & 15) * 8; float o[8];
            conv8_fin(rawc[uu], c * CHUNK, l0, 1024 + tens * 128 + g * 64 + lane, cwl, cwl + 4 * CONVD, o);
            bf16_t* dst = tens ? cN : bN;
#pragma unroll
            for (int i = 0; i < 8; ++i) dst[(l0 + i) * LN + lane] = f2bf(o[i]); }
        (void)wave_chunk_scan(DT, row0, hd, __expf(p.a_log[hd]), w_acs, w_dt, lane);
        __syncthreads();
        { bf16x8 ca[2];
#pragma unroll
          for (int k = 0; k < 2; ++k) ca[k] = *(const bf16x8*)(cN + (16 * wave + fr) * LN + k * 32 + fq * 8);
#pragma unroll
          for (int ts = 0; ts < 8; ++ts) {
              if (ts <= wave + 1) { f32x4 cb = {0.f, 0.f, 0.f, 0.f};
#pragma unroll
                  for (int k = 0; k < 2; ++k) { const bf16x8 bb = *(const bf16x8*)(bN + (16 * ts + fr) * LN + k * 32 + fq * 8); cb = __builtin_amdgcn_mfma_f32_16x16x32_bf16(ca[k], bb, cb, 0, 0, 0); }
#pragma unroll
                  for (int j = 0; j < 4; ++j) cbL[(16 * wave + fq * 4 + j) * LT + 16 * ts + fr] = f2bf(cb[j]); } } }
        bf16x8 bx[4][4], sp[2][4];
#pragma unroll
        for (int kk = 0; kk < 4; ++kk) { bf16_t rawx[4][11];
#pragma unroll
            for (int pt = 0; pt < 4; ++pt) conv8_load(xb, c * CHUNK, 32 * kk + 8 * fq, hd * 64 + 16 * pt + fr, rawx[pt]);
            asm volatile("" ::: "memory");
#pragma unroll
            for (int pt = 0; pt < 4; ++pt) { float o[8]; conv8_fin(rawx[pt], c * CHUNK, 32 * kk + 8 * fq, hd * 64 + 16 * pt + fr, cwl, cwl + 4 * CONVD, o); bx[kk][pt] = pack8f(o); } }
        const int ih = (b * NCH + c) * NHS + hd;
#pragma unroll
        for (int k2 = 0; k2 < 2; ++k2) { f32x4 sr[4][2];
#pragma unroll
            for (int pt = 0; pt < 4; ++pt) { const float* q = ST + (size_t)ih * 4096 + (16 * pt + fr) * 64 + 32 * k2 + 8 * fq; sr[pt][0] = *(const f32x4*)q; sr[pt][1] = *(const f32x4*)(q + 4); }
            asm volatile("" ::: "memory");
#pragma unroll
            for (int pt = 0; pt < 4; ++pt) { const f32x4 s0 = sr[pt][0], s1 = sr[pt][1];
                u32x4 w; w.x = cvt_pk_bf16(s0[0], s0[1]); w.y = cvt_pk_bf16(s0[2], s0[3]); w.z = cvt_pk_bf16(s1[0], s1[1]); w.w = cvt_pk_bf16(s1[2], s1[3]); sp[k2][pt] = __builtin_bit_cast(bf16x8, w); } }
        const float dsk = p.d_skip[hd];
        __syncthreads();
#pragma unroll 1
        for (int lt = 0; lt < 8; ++lt) {
            float zv[4][4];
#pragma unroll
            for (int j = 0; j < 4; ++j)
#pragma unroll
                for (int pt = 0; pt < 4; ++pt) zv[j][pt] = bf2f(P[(row0 + 16 * lt + fq * 4 + j) * DM + SEG_ZSSM + hd * 64 + 16 * pt + fr]);
            f32x4 acc[4];
#pragma unroll
            for (int pt = 0; pt < 4; ++pt) acc[pt] = (f32x4){0.f, 0.f, 0.f, 0.f};
            int l = 16 * lt + fr; asm volatile("" : "+v"(l)); const float al = w_acs[l];
#pragma unroll
            for (int kk = 0; kk < 4; ++kk) { if (32 * kk <= 16 * lt + 15) {
                const int s0 = 32 * kk + 8 * fq;
                const u32x4 cw4 = *(const u32x4*)(cbL + l * LT + s0);
                const f32x4 ac0 = *(const f32x4*)(w_acs + s0), ac1 = *(const f32x4*)(w_acs + s0 + 4), dd0 = *(const f32x4*)(w_dt + s0), dd1 = *(const f32x4*)(w_dt + s0 + 4);
                float v[8] = {bflo(cw4.x), bfhi(cw4.x), bflo(cw4.y), bfhi(cw4.y), bflo(cw4.z), bfhi(cw4.z), bflo(cw4.w), bfhi(cw4.w)};
#pragma unroll
                for (int i = 0; i < 4; ++i) { v[i] *= __expf(al - ac0[i]) * dd0[i]; v[4 + i] *= __expf(al - ac1[i]) * dd1[i]; }
#pragma unroll
                for (int i = 0; i < 8; ++i) { v[i] = (s0 + i <= l) ? v[i] : 0.f; if (s0 + i == l) v[i] += dsk; }
                const bf16x8 a = pack8f(v);
#pragma unroll
                for (int pt = 0; pt < 4; ++pt) acc[pt] = __builtin_amdgcn_mfma_f32_16x16x32_bf16(a, bx[kk][pt], acc[pt], 0, 0, 0); } }
            const float ea = __expf(al);
#pragma unroll
            for (int k2 = 0; k2 < 2; ++k2) { const u32x4 cw4 = *(const u32x4*)(cN + l * LN + 32 * k2 + 8 * fq);
                float v[8] = {bflo(cw4.x), bfhi(cw4.x), bflo(cw4.y), bfhi(cw4.y), bflo(cw4.z), bfhi(cw4.z), bflo(cw4.w), bfhi(cw4.w)};
#pragma unroll
                for (int i = 0; i < 8; ++i) v[i] *= ea;
                const bf16x8 a = pack8f(v);
#pragma unroll
                for (int pt = 0; pt < 4; ++pt) acc[pt] = __builtin_amdgcn_mfma_f32_16x16x32_bf16(a, sp[k2][pt], acc[pt], 0, 0, 0); }
#pragma unroll
            for (int j = 0; j < 4; ++j) { const size_t row = row0 + 16 * lt + fq * 4 + j; float sq = 0.f;
                bf16_t* zp = P + row * DM + SEG_ZSSM + hd * 64;
#pragma unroll
                for (int pt = 0; pt < 4; ++pt) { const float yg = acc[pt][j] * siluf_(zv[j][pt]); sq += yg * yg; zp[16 * pt + fr] = f2bf(yg); }
                sq += DPPF(sq, 0xB1); sq += DPPF(sq, 0x4E); sq += DPPF(sq, 0x141); sq += DPPF(sq, 0x140);
                if (fr == 0) SSQ[row * 16 + hd] = sq; }
        }
        __syncthreads();
    }
}
__device__ __forceinline__ void phase_qknorm(const Params& p, int lane, int wave) {
    const bf16_t* P = (const bf16_t*)(p.ws + WS_P); unsigned* N2 = (unsigned*)(p.ws + WS_NORM2);
    const int gw = blockIdx.x * 8 + wave, NGW = gridDim.x * 8;
    for (int ch = gw + NGW; ch < M / 16; ch += NGW) {
        float mq0 = 0.f, mq1 = 0.f, mk0 = 0.f, mk1 = 0.f, dn0 = 3.0e38f, dn1 = 3.0e38f;
#pragma unroll 4
        for (int rr = 0; rr < 16; ++rr) {
            const bf16_t* rp = P + (size_t)(ch * 16 + rr) * DM + 8 * lane;
            const u32x4 a = *(const u32x4*)(rp + SEG_Q), b = *(const u32x4*)(rp + SEG_Q + 512), c = *(const u32x4*)(rp + SEG_K), d = *(const u32x4*)(rp + SEG_K + 512);
#define SQ8(V_) ((bflo(V_.x) * bflo(V_.x) + bfhi(V_.x) * bfhi(V_.x)) + (bflo(V_.y) * bflo(V_.y) + bfhi(V_.y) * bfhi(V_.y)) + (bflo(V_.z) * bflo(V_.z) + bfhi(V_.z) * bfhi(V_.z)) + (bflo(V_.w) * bflo(V_.w) + bfhi(V_.w) * bfhi(V_.w)))
            float sa = SQ8(a), sb = SQ8(b), sc = SQ8(c), sd = SQ8(d);
#undef SQ8
#define DOT8(A_, B_) ((bflo(A_.x) * bflo(B_.x) + bfhi(A_.x) * bfhi(B_.x)) + (bflo(A_.y) * bflo(B_.y) + bfhi(A_.y) * bfhi(B_.y)) + (bflo(A_.z) * bflo(B_.z) + bfhi(A_.z) * bfhi(B_.z)) + (bflo(A_.w) * bflo(B_.w) + bfhi(A_.w) * bfhi(B_.w)))
            float da = DOT8(a, c), db = DOT8(b, d);
#undef DOT8
#define ROWSUM(v) do { v += DPPF(v, 0xB1); v += DPPF(v, 0x4E); v += DPPF(v, 0x141); v += DPPF(v, 0x140); } while (0)
            ROWSUM(sa); ROWSUM(sb); ROWSUM(sc); ROWSUM(sd); ROWSUM(da); ROWSUM(db);
#undef ROWSUM
            mq0 = fmaxf(mq0, sa); mq1 = fmaxf(mq1, sb); mk0 = fmaxf(mk0, sc); mk1 = fmaxf(mk1, sd); dn0 = fminf(dn0, da); dn1 = fminf(dn1, db);
        }
        if ((lane & 15) == 0) { const int b = (ch * 16) >> 13, h0 = lane >> 4;
            atomicMax(N2 + (b * 8 + h0) * 2 + 0, __float_as_uint(mq0)); atomicMax(N2 + (b * 8 + 4 + h0) * 2 + 0, __float_as_uint(mq1));
            atomicMax(N2 + (b * 8 + h0) * 2 + 1, __float_as_uint(mk0)); atomicMax(N2 + (b * 8 + 4 + h0) * 2 + 1, __float_as_uint(mk1));
            const int qb = ((ch * 16) & (SEQ - 1)) >> 8; unsigned* q0 = (unsigned*)(p.ws + WS_QBD) + ((b * 8 + h0) * 32 + qb) * 2; unsigned* q1 = (unsigned*)(p.ws + WS_QBD) + ((b * 8 + 4 + h0) * 32 + qb) * 2;
            atomicMax(q0, __float_as_uint(mq0)); atomicMin((int*)q0 + 1, fkey(dn0)); atomicMax(q1, __float_as_uint(mq1)); atomicMin((int*)q1 + 1, fkey(dn1)); }
    }
}
__device__ __forceinline__ void att_ref(att::BlockRef& r, bf16_t* P, const float* FL, int unit, int jlo) {
    const int bh = unit & 31, qb = 31 - (unit >> 5);
    const int b = bh >> 3, h = bh & 7; const size_t rowb = (size_t)b * SEQ;
    r.Q = P + SEG_Q + (rowb + (size_t)qb * 256) * DM + h * 128; r.K = P + SEG_K + rowb * DM + h * 128; r.V = P + SEG_V + rowb * DM + h * 128;
    r.O = P + SEG_ZATT + (rowb + (size_t)qb * 256) * DM + h * 128; r.F = FL + (size_t)bh * SEQ; r.P0 = qb * 256; r.fref = r.F[r.P0]; r.jlo = jlo;
}
__device__ __forceinline__ void att_pop(const Params& p, const float* FL, volatile int* slot, int lane) {
    asm volatile("" : "+v"(lane));
    unsigned u = 0; if (lane == 0) u = atomicAdd((unsigned*)(p.ws + WS_QCTR), 1u);
    u = __builtin_amdgcn_readfirstlane(u);
    int jlo = 0;
    if (u < 1024u) {
        const int bh = u & 31, qb = 31 - (int)(u >> 5), P0 = qb * 256, NTf = 4 * qb + 4;
        const unsigned* n2 = (const unsigned*)(p.ws + WS_NORM2) + bh * 2;
        const float q2 = __uint_as_float(n2[0]), k2 = __uint_as_float(n2[1]);
        const unsigned* qbd = (const unsigned*)(p.ws + WS_QBD) + (bh * 32 + qb) * 2;
        const float qb2 = __uint_as_float(qbd[0]); const int dk = (int)qbd[1];
        float thr = (106.f + 2.f * sqrtf(q2 * k2) * att::SCALE) * LOG2E;
        if (dk != 0x7fffffff && qb2 > 0.f) thr = (106.f + (sqrtf(qb2 * k2) - fkey_inv(dk)) * att::SCALE) * LOG2E;
        const float* F = FL + (size_t)bh * SEQ;
        const float bound = F[P0] + thr;
        const int t0 = 2 * lane, t1 = 2 * lane + 1;
        const float f0 = F[64 * (t0 < NTf ? t0 : NTf - 1) + 63], f1 = F[64 * (t1 < NTf ? t1 : NTf - 1) + 63];
        const unsigned long long b0 = __ballot(f0 < bound), b1 = __ballot(f1 < bound);
        const int g0 = b0 ? (int)__builtin_ctzll(b0) * 2 : 128, g1 = b1 ? (int)__builtin_ctzll(b1) * 2 + 1 : 128;
        jlo = g0 < g1 ? g0 : g1;
        if (jlo > NTf - 1) jlo = NTf - 1;
    }
    if (lane == 0) { slot[0] = (int)u; slot[1] = jlo; }
}
__device__ __forceinline__ void phase_attn(const Params& p, unsigned char* lds, int lane, int wave) {
    bf16_t* P = (bf16_t*)(p.ws + WS_P); const float* FL = (const float*)(p.ws + WS_FL);
    volatile int* slot = (volatile int*)(lds + att::ATT_LDS);
    if (wave == 0) att_pop(p, FL, slot, lane);
    __syncthreads();
    int u = __builtin_amdgcn_readfirstlane(slot[0]), jl = __builtin_amdgcn_readfirstlane(slot[1]);
    __syncthreads();
    if (u >= 1024) return;
    att::BlockRef cur; att_ref(cur, P, FL, u, jl);
    att::Seam S;
    att::attn_prime(cur, (char*)lds, S, wave);
    for (;;) {
        if (wave == 0) att_pop(p, FL, slot, lane);
        __syncthreads();
        const int un = __builtin_amdgcn_readfirstlane(slot[0]), jn = __builtin_amdgcn_readfirstlane(slot[1]);
        const bool last = un >= 1024;
        att::BlockRef nxt; if (last) nxt = cur; else att_ref(nxt, P, FL, un, jn);
        att::attn_block(cur, nxt, (char*)lds, S, wave);
        if (last) break;
        cur = nxt;
    }
}
__device__ __forceinline__ void phase_final(const Params& p, int lane, int wave) {
    const float* SSQ2 = (const float*)(p.ws + WS_SSQ2);
    const int gw = blockIdx.x * 8 + wave, NGW = gridDim.x * 8;
    f32x4 fw[4];
#pragma unroll
    for (int j = 0; j < 4; ++j) fw[j] = *(const f32x4*)(p.final_norm_w + 256 * j + 4 * lane);
    for (int m = gw; m < M; m += NGW) {
        const f32x4* sp = (const f32x4*)(SSQ2 + (size_t)m * 16); const f32x4 a = sp[0], b = sp[1], c = sp[2], d = sp[3];
        const float s = ((a[0] + a[1]) + (a[2] + a[3])) + ((b[0] + b[1]) + (b[2] + b[3])) + ((c[0] + c[1]) + (c[2] + c[3])) + ((d[0] + d[1]) + (d[2] + d[3]));
        const float rstd = rsqrtf(s * (1.f / DM) + EPS);
        f32x4* xr = (f32x4*)(p.out + (size_t)m * DM) + lane;
#pragma unroll
        for (int j = 0; j < 4; ++j) xr[64 * j] = xr[64 * j] * rstd * fw[j];
    }
}


__device__ __forceinline__ void phase_gemm1(const Params& p, unsigned char* lds, int tid, int lane, int wave) {
    bf16_t* P = (bf16_t*)(p.ws + WS_P);
    phase_fcum(p, lds, tid, lane, wave);
    pg8::Order<1> S; S.init(M, NPROJ, gridDim.x, blockIdx.x);
    S.A0 = (const char*)p.out + OUT_H; S.A1 = S.A0; S.B = (const char*)(p.ws + WS_WIN); S.tstepA = (size_t)256 * DM * 2;
    pg8::EpiProj E{P, (bf16_t*)((unsigned char*)p.out + OUT_GATT)};
    pg8::gemm_phase<pg8::EpiProj, pg8::Order<1>>((LAS unsigned char*)lds, DM, DM, S, E, wave);
}
__device__ __forceinline__ void phase_merge(const Params& p, unsigned char* lds, const int wave) {
    bf16_t* P = (bf16_t*)(p.ws + WS_P);
    pg8::Order<2> S; S.init(M, DM, gridDim.x, blockIdx.x);
    S.A0 = (const char*)(P + SEG_ZSSM); S.A1 = (const char*)(P + SEG_ZATT); S.B = (const char*)(p.ws + WS_WP); S.tstepA = (size_t)256 * DM * 2;
    float* rtab = (float*)(lds + 131072);
    { const float* ssq = (const float*)(p.ws + WS_SSQ); const int tid = wave * 64 + fresh_lane();
      for (int slot = 0; slot < 16; ++slot) { pg8::Unit t; if (!S.next(slot * 2, t)) break;
          const f32x4* sp = (const f32x4*)(ssq + (size_t)(t.pm * 256 + (tid >> 1)) * 16 + (tid & 1) * 8); const f32x4 a = sp[0], b = sp[1];
          float v = ((a[0] + a[1]) + (a[2] + a[3])) + ((b[0] + b[1]) + (b[2] + b[3])); v += __shfl_xor(v, 1);
          if ((tid & 1) == 0) rtab[slot * 256 + (tid >> 1)] = rsqrtf(v * (1.f / 1024.f) + EPS); }
      __syncthreads(); }
    pg8::EpiMerge E{P + SEG_GSSM, (const bf16_t*)((unsigned char*)p.out + OUT_GATT), P + SEG_Q, rtab, p.b_gate};
    pg8::gemm_phase<pg8::EpiMerge, pg8::Order<2>>((LAS unsigned char*)lds, DM, DM, S, E, wave);
}
__device__ __forceinline__ void phase_outg(const Params& p, unsigned char* lds, const int wave) {
    bf16_t* P = (bf16_t*)(p.ws + WS_P);
    pg8::Order<1> S; S.init(M, DM, gridDim.x, blockIdx.x);
    S.A0 = (const char*)(P + SEG_Q); S.A1 = S.A0; S.B = (const char*)(p.ws + WS_WOUT); S.tstepA = (size_t)256 * DM * 2;
    pg8::EpiOutNorm E{p.x, p.out, (const float*)(p.ws + WS_ADA), (float*)(p.ws + WS_SSQ2), (unsigned*)(p.ws + WS_PCNT), p.final_norm_w};
    pg8::gemm_phase<pg8::EpiOutNorm, pg8::Order<1>>((LAS unsigned char*)lds, DM, DM, S, E, wave);
}

constexpr int NPHASE = 8;
__global__ void __launch_bounds__(NTHREADS, 2) mega_fwd(Params p) {
    extern __shared__ __attribute__((aligned(16))) unsigned char lds[];
    const int wave = __builtin_amdgcn_readfirstlane(threadIdx.x >> 6);
#define FRESH() const int lane = fresh_lane(); const int tid = wave * 64 + lane; (void)tid; (void)lane
    const int lo = p.ph_lo, hi = p.ph_hi;
#define IN(k) (lo <= (k) && (k) < hi)
#define SEAM(k) do { if (IN(k) && IN((k) + 1)) { if ((k) == 0) cg::this_grid().sync(); else grid_barrier((unsigned*)(p.ws + WS_QCTR) + 64, (unsigned)(k) * gridDim.x, wave); } } while (0)
#ifndef PROBE_MASK
#define PROBE_MASK 0
#endif
#if PROBE_MASK & 1
    if (IN(0)) { FRESH(); phase0(p, lds, tid, lane, wave); }
#endif
    if (IN(0)) { FRESH(); phase0(p, lds, tid, lane, wave); }
    SEAM(0);
#if PROBE_MASK & 2
    if (IN(1)) { FRESH(); phase1(p, lds, tid, lane, wave); }
#endif
    if (IN(1)) { FRESH(); phase1(p, lds, tid, lane, wave); }
    SEAM(1);
#if PROBE_MASK & 4
    if (IN(2)) { FRESH(); phase_gemm1(p, lds, tid, lane, wave); }
#endif
    if (IN(2)) { FRESH(); phase_gemm1(p, lds, tid, lane, wave); }
    SEAM(2);
#if PROBE_MASK & 8
    if (IN(3)) { FRESH(); phase_ssd_a(p, lds, tid, lane, wave); }
#endif
    if (IN(3)) { { FRESH(); phase_ssd_a(p, lds, tid, lane, wave); } { FRESH(); phase_qknorm(p, lane, wave); } }
    SEAM(3);
    if (IN(4)) { { FRESH(); phase_ssd_scan(p, tid); } { FRESH(); phase_attn(p, lds, lane, wave); } }
    SEAM(4);
    if (IN(5)) { FRESH(); phase_ssd_c(p, lds, tid, lane, wave); }
    SEAM(5);
#if PROBE_MASK & 64
    if (IN(6)) { phase_merge(p, lds, wave); }
#endif
    if (IN(6)) { phase_merge(p, lds, wave); }
    SEAM(6);
#if PROBE_MASK & 128
    if (IN(7)) { phase_outg(p, lds, wave); }
#endif
    if (IN(7)) { phase_outg(p, lds, wave); }

#undef IN
#undef SEAM
}

extern "C" void kernel_launch(void* const* d_in, const int* in_sizes, int n_in, void* d_out, int out_size, void* d_ws, size_t ws_size, hipStream_t stream) {
    static int grid = 0;
    if (grid == 0) {
        if (n_in != 18 || out_size != M * DM || ws_size < WS_END) { fprintf(stderr, "kernel_launch: unexpected shapes (n_in %d out %d ws %zu)\n", n_in, out_size, ws_size); grid = -1; return; }
        int dev = 0, cus = 0, per_cu = 0;
        (void)hipGetDevice(&dev); (void)hipDeviceGetAttribute(&cus, hipDeviceAttributeMultiprocessorCount, dev);
        if (hipFuncSetAttribute((const void*)mega_fwd, hipFuncAttributeMaxDynamicSharedMemorySize, LDS_BYTES) != hipSuccess) { fprintf(stderr, "kernel_launch: hipFuncSetAttribute failed\n"); grid = -1; return; }
        if (hipOccupancyMaxActiveBlocksPerMultiprocessor(&per_cu, (const void*)mega_fwd, NTHREADS, LDS_BYTES) != hipSuccess || per_cu < 1) per_cu = 1;
        (void)hipGetLastError();
        grid = cus * per_cu; if (grid <= 0) grid = 256;
    }
    if (grid < 0) return;
    Params p{};
    const float** pp = (const float**)&p;
    for (int i = 0; i < 18; ++i) pp[i] = (const float*)d_in[i];
    p.out = (float*)d_out; p.ws = (unsigned char*)d_ws;
#if MK_N_LAUNCHES == 1
    p.ph_lo = 0; p.ph_hi = NPHASE;
    void* args[] = {&p};
    hipError_t e = hipLaunchCooperativeKernel((const void*)mega_fwd, dim3(grid), dim3(NTHREADS), args, LDS_BYTES, stream);
    if (e != hipSuccess) fprintf(stderr, "kernel_launch: cooperative launch failed: %s (grid %d)\n", hipGetErrorString(e), grid);
#else
    for (int ph = 0; ph < NPHASE; ++ph) { p.ph_lo = ph; p.ph_hi = ph + 1; hipLaunchKernelGGL(mega_fwd, dim3(grid), dim3(NTHREADS), LDS_BYTES, stream, p); }
#endif
}
```

```cpp
#include <hip/hip_runtime.h>
#include <hip/hip_cooperative_groups.h>
#include <cstdio>
#include <cstdint>
namespace cg = cooperative_groups;

#define LAS __attribute__((address_space(3)))
typedef unsigned short bf16_t;
typedef short bf16x8 __attribute__((ext_vector_type(8)));
typedef short s16x4 __attribute__((ext_vector_type(4)));
typedef float f32x4 __attribute__((ext_vector_type(4)));
typedef float f32x16 __attribute__((ext_vector_type(16)));
typedef unsigned u32x4 __attribute__((ext_vector_type(4)));
typedef unsigned u32x2 __attribute__((ext_vector_type(2)));
typedef float f32x2 __attribute__((ext_vector_type(2)));

#ifndef MK_N_LAUNCHES
#define MK_N_LAUNCHES 1
#endif

constexpr int NB = 4, SEQ = 8192, DM = 1024, M = NB * SEQ;
constexpr int IN_COLS = 8472;
constexpr int LDP = 7424;
constexpr int OFF_ZSSM = 0, OFF_XBC = 1024, OFF_Q = 2304, OFF_K = 3328, OFF_V = 4352, OFF_ZATT = 5376, OFF_GSSM = 6400;
constexpr int NPROJ = 8448;
constexpr int NHS = 16, NHA = 8, NCH = 64, CHUNK = 128, CONVD = 1280;
constexpr float EPS = 1e-6f;
constexpr float LOG2E = 1.4426950408889634f;

constexpr size_t MiB = 1u << 20;
constexpr size_t WS_P = 0;
constexpr size_t WS_WIN = 464 * MiB;
constexpr size_t WS_WP = 481 * MiB;
constexpr size_t WS_WOUT = 485 * MiB;
constexpr size_t WS_WSMALL = 487 * MiB;
constexpr size_t WS_ADA = 487 * MiB + 128 * 1024;
constexpr size_t WS_DT = 488 * MiB;
constexpr size_t WS_LOGF = 490 * MiB;
constexpr size_t WS_FL = 491 * MiB;
constexpr size_t WS_ACH = 492 * MiB;
constexpr size_t WS_NORM2 = 492 * MiB + 32 * 1024;
constexpr size_t WS_QBD = 492 * MiB + 40 * 1024;
constexpr size_t WS_QCTR = 492 * MiB + 48 * 1024;
constexpr size_t WS_PCNT = 492 * MiB + 64 * 1024;
constexpr size_t WS_SSQ = 493 * MiB;
constexpr size_t WS_SSQ2 = 495 * MiB;
constexpr size_t WS_END = 497 * MiB;
constexpr size_t OUT_H = 0, OUT_ST = 0, OUT_GATT = 64 * MiB;

constexpr int LDS_BYTES = 147456;
constexpr int NTHREADS = 512;

struct Params {
    const float *x, *c, *w_ada, *b_ada, *norm_w, *w_in, *conv_w, *conv_b, *dt_bias, *a_log, *d_skip, *ssm_norm_w, *b_f, *b_gate,
        *w_proj_ssm, *w_proj_att, *w_out, *final_norm_w;
    float* out; unsigned char* ws; int ph_lo, ph_hi;
};

typedef __bf16 bf16v2_t __attribute__((ext_vector_type(2)));
__device__ __forceinline__ unsigned cvt_pk_bf16(float lo, float hi) { const f32x2 v = {lo, hi}; return __builtin_bit_cast(unsigned, __builtin_convertvector(v, bf16v2_t)); }
__device__ __forceinline__ float bf2f(bf16_t v) { return __uint_as_float(((unsigned)v) << 16); }
__device__ __forceinline__ float bflo(unsigned w) { return __uint_as_float(w << 16); }
__device__ __forceinline__ float bfhi(unsigned w) { return __uint_as_float(w & 0xffff0000u); }
__device__ __forceinline__ bf16_t f2bf(float f) { return (bf16_t)(cvt_pk_bf16(f, 0.f) & 0xffffu); }
#define DPPF(v, ctrl) __builtin_bit_cast(float, __builtin_amdgcn_update_dpp(0, __builtin_bit_cast(int, (v)), (ctrl), 0xf, 0xf, true))
__device__ __forceinline__ float wave_sum(float v) {
    v += DPPF(v, 0xB1); v += DPPF(v, 0x4E); v += DPPF(v, 0x141); v += DPPF(v, 0x140);
    { auto rr = __builtin_amdgcn_permlane16_swap(__float_as_uint(v), __float_as_uint(v), false, false); v = __uint_as_float(rr[0]) + __uint_as_float(rr[1]); }
    { auto rr = __builtin_amdgcn_permlane32_swap(__float_as_uint(v), __float_as_uint(v), false, false); v = __uint_as_float(rr[0]) + __uint_as_float(rr[1]); }
    return v;
}
__device__ __forceinline__ int fkey(float f) { const int b = __float_as_int(f); return b >= 0 ? b : b ^ 0x7fffffff; }
__device__ __forceinline__ float fkey_inv(int k) { return __int_as_float(k >= 0 ? k : k ^ 0x7fffffff); }
__device__ __forceinline__ float sigmoidf_(float v) { return __builtin_amdgcn_rcpf(1.f + __expf(-v)); }
__device__ __forceinline__ float siluf_(float v) { return v * __builtin_amdgcn_rcpf(1.f + __expf(-v)); }
#define LDS_WAIT() asm volatile("s_waitcnt lgkmcnt(0)" ::: "memory")
__device__ __forceinline__ int fresh_lane() { int l; asm volatile("v_mbcnt_lo_u32_b32 %0, -1, 0\n\tv_mbcnt_hi_u32_b32 %0, -1, %0" : "=v"(l)); return l; }
__device__ __forceinline__ void grid_barrier(unsigned* bar, unsigned target, int wave) {
    asm volatile("s_waitcnt vmcnt(0)" ::: "memory");
    __syncthreads();
    if (wave == 0 && fresh_lane() == 0) {
        __builtin_amdgcn_fence(__ATOMIC_RELEASE, "agent");
        asm volatile("s_waitcnt vmcnt(0)" ::: "memory");
        __hip_atomic_fetch_add(bar, 1u, __ATOMIC_RELAXED, __HIP_MEMORY_SCOPE_AGENT);
        unsigned spins = 0;
        while (__hip_atomic_load(bar, __ATOMIC_RELAXED, __HIP_MEMORY_SCOPE_AGENT) < target) { __builtin_amdgcn_s_sleep(1); if (++spins > (1u << 22)) break; }
        __builtin_amdgcn_fence(__ATOMIC_ACQUIRE, "agent");
        asm volatile("s_waitcnt vmcnt(0)" ::: "memory");
    }
    __syncthreads();
}

namespace pg8 {
constexpr int BM = 256, BK = 64, HALF = 128, HTB = HALF * BK * 2, STAGE_BYTES = 8 * HTB, NXCD = 8, WGM = 8;
__device__ __forceinline__ int lds_byte(int r, int c) { const int st = (r >> 4) * 2 + (c >> 5), rr = r & 15, cc = c & 31, ob = rr * 64 + cc * 2; return st * 1024 + (ob ^ (((ob >> 9) & 1) << 5)); }
__device__ __forceinline__ void stage_rc(int b, int& R, int& C) { const int st = b / 1024, sb = b % 1024, swz = sb ^ (((sb >> 9) & 1) << 5); R = (st >> 1) * 16 + swz / 64; C = (st & 1) * 32 + (swz % 64) / 2; }
__device__ __forceinline__ int perm32(int rho) { const int n = rho >> 4, i = rho & 15; return 8 * (i >> 2) + 4 * n + (i & 3); }

struct Unit { int pm, pn, br, slot; };
template <int NBR, int WGM_ = WGM> struct Order {
    int nM, nN, nwg, G, c;
    const char* A0; const char* A1; const char* B; size_t tstepA;
    __device__ void init(int M_, int N_, int G_, int c_) { nM = M_ / BM; nN = N_ / BM; nwg = nM * nN; G = G_; c = c_; }
    __device__ bool next(int i, Unit& u) const {
        const long L = (long)(i / NBR) * G + c; if (L >= nwg) return false;
        int wgid = (int)L; { const int q = nwg / NXCD, r = nwg % NXCD, xcd = wgid % NXCD, off = wgid / NXCD; wgid = (xcd < r ? xcd * (q + 1) : r * (q + 1) + (xcd - r) * q) + off; }
        const int nig = WGM_ * nN, gid = wgid / nig, fm = gid * WGM_, gsz = (nM - fm) < WGM_ ? (nM - fm) : WGM_;
        u.pm = fm + ((wgid % nig) % gsz); u.pn = (wgid % nig) / gsz; u.br = i % NBR; u.slot = i / NBR; return true;
    }
    __device__ __forceinline__ const char* aptr(const Unit& u) const { return (u.br ? A1 : A0) + (size_t)u.pm * tstepA; }
    __device__ __forceinline__ const char* bptr(const Unit& u, int K) const { return B + (size_t)(u.br * nN + u.pn) * (size_t)(BM * K * 2); }
};

template <class Epi, class Sched>
__device__ __forceinline__ void gemm_phase(LAS unsigned char* lds, const int K, const int lda, const Sched& S, const Epi& E, const int wid) {
    const int lane = fresh_lane(), tid = wid * 64 + lane, wr = wid >> 2, wc = wid & 3, fr = lane & 15, fq = lane >> 4;
    const int nt = K / BK;
    unsigned voffA[2], voffB[2];
#pragma unroll
    for (int i = 0; i < 2; ++i) { int R, C; stage_rc(tid * 16 + i * 8192, R, C); const int Rb = (R & ~31) + perm32(R & 31);
        voffA[i] = (unsigned)(R * lda + C) * 2u; voffB[i] = (unsigned)(Rb * K + C) * 2u; }
    const size_t kstep = (size_t)(BK * 2);
    const size_t hstepA = (size_t)HALF * lda * 2, hstepB = (size_t)HALF * K * 2;
    const unsigned ldsw = (unsigned)wid * 1024u;
    const int aoff = lds_byte(wr * 64 + fr, fq * 8), boff = lds_byte(wc * 32 + fr, fq * 8);
#define PG8_SA(b, h) (((b) * 2 + (h)) * HTB)
#define PG8_SB(b, h) ((4 + (b) * 2 + (h)) * HTB)
#define PG8_STAGE(bufoff, gbase, voff) do { _Pragma("unroll") for (int _i = 0; _i < 2; ++_i) \
        __builtin_amdgcn_global_load_lds((const unsigned*)((const char*)(gbase) + (voff)[_i]), (LAS unsigned*)(lds + (bufoff) + ldsw + _i * 8192), 16, 0, 0); } while (0)
#define PG8_LDA(dst, b, h) do { _Pragma("unroll") for (int m = 0; m < 4; ++m) _Pragma("unroll") for (int k = 0; k < 2; ++k) dst[m][k] = *(const LAS bf16x8*)(lds + PG8_SA(b, h) + aoff + m * 2048 + k * 1024); } while (0)
#define PG8_LDB(dst, b, h) do { _Pragma("unroll") for (int n = 0; n < 2; ++n) _Pragma("unroll") for (int k = 0; k < 2; ++k) dst[n][k] = *(const LAS bf16x8*)(lds + PG8_SB(b, h) + boff + n * 2048 + k * 1024); } while (0)
#define PG8_MMA(ai, bj, At, Bt) do { __builtin_amdgcn_s_setprio(1); _Pragma("unroll") for (int m = 0; m < 4; ++m) _Pragma("unroll") for (int n = 0; n < 2; ++n) _Pragma("unroll") for (int k = 0; k < 2; ++k) \
        acc[ai][bj][m][n] = __builtin_amdgcn_mfma_f32_16x16x32_bf16(Bt[n][k], At[m][k], acc[ai][bj][m][n], 0, 0, 0); __builtin_amdgcn_s_setprio(0); } while (0)
#define PG8_WAIT_V(n) asm volatile("s_waitcnt vmcnt(" #n ")" ::: "memory")
#define PG8_WAIT_L(n) asm volatile("s_waitcnt lgkmcnt(" #n ")" ::: "memory")
#define PG8_BAR __builtin_amdgcn_s_barrier()
#define PG8_SCHED __builtin_amdgcn_sched_barrier(0)
    Unit cur, nxt; int ui = 0;
    if (!S.next(0, cur)) return;
    f32x4 acc[2][2][4][2];
#pragma unroll
    for (int a = 0; a < 2; ++a)
#pragma unroll
        for (int b = 0; b < 2; ++b)
#pragma unroll
            for (int m = 0; m < 4; ++m)
#pragma unroll
                for (int n = 0; n < 2; ++n) acc[a][b][m][n] = (f32x4){0.f, 0.f, 0.f, 0.f};
    bf16x8 At[4][2], B0[2][2], B1[2][2];
    const char* cA = S.aptr(cur); const char* cB = S.bptr(cur, K);
    PG8_STAGE(PG8_SB(0, 0), cB, voffB); PG8_STAGE(PG8_SB(0, 1), cB + hstepB, voffB); PG8_STAGE(PG8_SA(0, 0), cA, voffA); PG8_STAGE(PG8_SA(0, 1), cA + hstepA, voffA);
    if (wr == 1) PG8_BAR;
    PG8_WAIT_V(2); PG8_BAR;
    PG8_STAGE(PG8_SB(1, 0), cB + kstep, voffB); PG8_STAGE(PG8_SA(1, 0), cA + kstep, voffA); PG8_STAGE(PG8_SB(1, 1), cB + hstepB + kstep, voffB);
    PG8_WAIT_V(6); PG8_BAR;
    for (;;) {
        const bool has_next = S.next(ui + 1, nxt);
        const char* nA = has_next ? S.aptr(nxt) : cA; const char* nB = has_next ? S.bptr(nxt, K) : cB;
        for (int t = 0; t < nt; t += 2) {
            const bool last = (t == nt - 2);
            const char* a1 = cA + (size_t)(t + 1) * kstep;
            const char* a2 = last ? nA : cA + (size_t)(t + 2) * kstep; const char* b2 = last ? nB : cB + (size_t)(t + 2) * kstep;
            const char* a3 = a2 + kstep; const char* b3 = b2 + kstep;
            PG8_LDB(B0, 0, 0); PG8_LDB(B1, 0, 1); PG8_SCHED; PG8_LDA(At, 0, 0); PG8_STAGE(PG8_SA(1, 1), a1 + hstepA, voffA);
            PG8_WAIT_V(8); PG8_WAIT_L(0); PG8_BAR; PG8_MMA(0, 0, At, B0); PG8_MMA(0, 1, At, B1); PG8_BAR; PG8_SCHED;
            PG8_LDA(At, 0, 1); PG8_STAGE(PG8_SB(0, 0), b2, voffB); PG8_STAGE(PG8_SB(0, 1), b2 + hstepB, voffB); PG8_STAGE(PG8_SA(0, 0), a2, voffA);
            PG8_WAIT_V(8); PG8_WAIT_L(0); PG8_BAR; PG8_MMA(1, 0, At, B0); PG8_MMA(1, 1, At, B1); PG8_BAR; PG8_SCHED;
            PG8_LDB(B0, 1, 0); PG8_LDB(B1, 1, 1); PG8_SCHED; PG8_LDA(At, 1, 0); PG8_STAGE(PG8_SA(0, 1), a2 + hstepA, voffA);
            PG8_WAIT_V(8); PG8_WAIT_L(0); PG8_BAR; PG8_MMA(0, 0, At, B0); PG8_MMA(0, 1, At, B1); PG8_BAR; PG8_SCHED;
            PG8_LDA(At, 1, 1); PG8_STAGE(PG8_SB(1, 0), b3, voffB); PG8_STAGE(PG8_SB(1, 1), b3 + hstepB, voffB); PG8_STAGE(PG8_SA(1, 0), a3, voffA);
            PG8_WAIT_V(8); PG8_WAIT_L(0); PG8_BAR; PG8_MMA(1, 0, At, B0); PG8_MMA(1, 1, At, B1); PG8_BAR; PG8_SCHED;
        }
        if (wr == 0) PG8_BAR;
        E(acc, cur, wr, wc, fr, fq);
        if (!has_next) break;
        if (!(Epi::CHAIN && cur.br == 0)) {
#pragma unroll
        for (int a = 0; a < 2; ++a)
#pragma unroll
            for (int b = 0; b < 2; ++b)
#pragma unroll
                for (int m = 0; m < 4; ++m)
#pragma unroll
                    for (int n = 0; n < 2; ++n) acc[a][b][m][n] = (f32x4){0.f, 0.f, 0.f, 0.f};
        }
        cur = nxt; cA = nA; cB = nB; ++ui;
        if (wr == 1) PG8_BAR;
    }
    PG8_WAIT_V(0);
    PG8_BAR;
#undef PG8_SA
#undef PG8_SB
#undef PG8_STAGE
#undef PG8_LDA
#undef PG8_LDB
#undef PG8_MMA
#undef PG8_WAIT_V
#undef PG8_WAIT_L
#undef PG8_BAR
#undef PG8_SCHED
}

struct EpiProj {
    static constexpr bool CHAIN = false;
    bf16_t* P; bf16_t* GA;
    __device__ __forceinline__ void operator()(const f32x4 (&acc)[2][2][4][2], const Unit& u, int wr, int wc, int fr, int fq) const {
        bf16_t* base; int ld;
        if (u.pn < 29) { base = P + u.pn * BM; ld = LDP; } else { base = GA + (u.pn - 29) * BM; ld = DM; }
        const int row0 = u.pm * BM + wr * 64 + fr, col0 = wc * 32 + 8 * fq;
#pragma unroll
        for (int ai = 0; ai < 2; ++ai)
#pragma unroll
            for (int m = 0; m < 4; ++m) { bf16_t* rowp = base + (size_t)(row0 + ai * HALF + m * 16) * ld + col0;
#pragma unroll
                for (int bj = 0; bj < 2; ++bj) { const f32x4 v0 = acc[ai][bj][m][0], v1 = acc[ai][bj][m][1];
                    u32x4 w; w.x = cvt_pk_bf16(v0[0], v0[1]); w.y = cvt_pk_bf16(v0[2], v0[3]); w.z = cvt_pk_bf16(v1[0], v1[1]); w.w = cvt_pk_bf16(v1[2], v1[3]);
                    __builtin_nontemporal_store(w, (u32x4*)(rowp + bj * HALF)); } }
    }
};
struct EpiMerge {
    static constexpr bool CHAIN = true;
    const bf16_t* GS; const bf16_t* GA; bf16_t* MG; const float* rstd_lds; const float* b_gate;
    __device__ __forceinline__ void operator()(f32x4 (&acc)[2][2][4][2], const Unit& u, int wr, int wc, int fr, int fq) const {
        const int row0 = u.pm * BM + wr * 64 + fr, col0 = u.pn * BM + wc * 32 + 8 * fq;
        f32x4 ba[2][2];
#pragma unroll
        for (int bj = 0; bj < 2; ++bj)
#pragma unroll
            for (int n = 0; n < 2; ++n) ba[bj][n] = *(const f32x4*)(b_gate + DM + col0 + bj * HALF + 4 * n);
        u32x4 ga[2][2], gs[2][2];
#define EM_LOAD(slot, r) do { const int row_ = row0 + ((r) >> 2) * HALF + ((r) & 3) * 16; \
            ga[slot][0] = __builtin_nontemporal_load((const u32x4*)(GA + (size_t)row_ * DM + col0)); ga[slot][1] = __builtin_nontemporal_load((const u32x4*)(GA + (size_t)row_ * DM + col0 + HALF)); \
            if (u.br == 0) { gs[slot][0] = __builtin_nontemporal_load((const u32x4*)(GS + (size_t)row_ * LDP + col0)); gs[slot][1] = __builtin_nontemporal_load((const u32x4*)(GS + (size_t)row_ * LDP + col0 + HALF)); } } while (0)
        EM_LOAD(0, 0);
#pragma unroll
        for (int r = 0; r < 8; ++r) {
            const int sl = r & 1, ai = r >> 2, m = r & 3;
            if (r + 1 < 8) { EM_LOAD(sl ^ 1, r + 1); }
            asm volatile("" ::: "memory");
            const int row = row0 + ai * HALF + m * 16;
            if (u.br == 0) {
                const float rs = rstd_lds[u.slot * 256 + ai * HALF + wr * 64 + m * 16 + fr];
#pragma unroll
                for (int bj = 0; bj < 2; ++bj) {
                    const u32x4 a4 = ga[sl][bj], s4 = gs[sl][bj];
                    f32x4 a0 = {bflo(a4.x), bfhi(a4.x), bflo(a4.y), bfhi(a4.y)}, a1 = {bflo(a4.z), bfhi(a4.z), bflo(a4.w), bfhi(a4.w)};
                    f32x4 s0 = {bflo(s4.x), bfhi(s4.x), bflo(s4.y), bfhi(s4.y)}, s1 = {bflo(s4.z), bfhi(s4.z), bflo(s4.w), bfhi(s4.w)};
                    a0 = a0 + ba[bj][0]; a1 = a1 + ba[bj][1];
                    const f32x4 bs0 = *(const f32x4*)(b_gate + col0 + bj * HALF), bs1 = *(const f32x4*)(b_gate + col0 + bj * HALF + 4);
                    s0 = s0 + bs0; s1 = s1 + bs1;
#pragma unroll
                    for (int e = 0; e < 4; ++e) { s0[e] = sigmoidf_(s0[e]) * rs * (1.f + __expf(-fmaxf(a0[e], -80.f))); s1[e] = sigmoidf_(s1[e]) * rs * (1.f + __expf(-fmaxf(a1[e], -80.f))); }
                    acc[ai][bj][m][0] = acc[ai][bj][m][0] * s0; acc[ai][bj][m][1] = acc[ai][bj][m][1] * s1; }
            } else {
                bf16_t* mp = MG + (size_t)row * LDP + col0;
#pragma unroll
                for (int bj = 0; bj < 2; ++bj) {
                    const u32x4 a4 = ga[sl][bj];
                    f32x4 a0 = {bflo(a4.x), bfhi(a4.x), bflo(a4.y), bfhi(a4.y)}, a1 = {bflo(a4.z), bfhi(a4.z), bflo(a4.w), bfhi(a4.w)};
                    a0 = a0 + ba[bj][0]; a1 = a1 + ba[bj][1];
#pragma unroll
                    for (int e = 0; e < 4; ++e) { a0[e] = sigmoidf_(fmaxf(a0[e], -80.f)); a1[e] = sigmoidf_(fmaxf(a1[e], -80.f)); }
                    const f32x4 v0 = a0 * acc[ai][bj][m][0], v1 = a1 * acc[ai][bj][m][1];
                    u32x4 w; w.x = cvt_pk_bf16(v0[0], v0[1]); w.y = cvt_pk_bf16(v0[2], v0[3]); w.z = cvt_pk_bf16(v1[0], v1[1]); w.w = cvt_pk_bf16(v1[2], v1[3]);
                    *(u32x4*)(mp + bj * HALF) = w; }
            }
        }
#undef EM_LOAD
    }
};
struct EpiOutNorm {
    static constexpr bool MUT = true, CHAIN = false;
    const float* x; float* out; const float* ada; float* ssq2; unsigned* cnt; const float* fnw;
    __device__ __forceinline__ void operator()(f32x4 (&acc)[2][2][4][2], const Unit& u, int wr, int wc, int fr, int fq) const {
        const int row0 = u.pm * BM + wr * 64 + fr, col0 = u.pn * BM + wc * 32 + 8 * fq;
        const float* gate = ada + (size_t)(u.pm >> 5) * 3072 + 2048;
        f32x4 gt[2][2];
#pragma unroll
        for (int bj = 0; bj < 2; ++bj)
#pragma unroll
            for (int n = 0; n < 2; ++n) gt[bj][n] = *(const f32x4*)(gate + col0 + bj * HALF + 4 * n);
        f32x4 xv[2][2][2];
#define EO_LOAD(slot, r) do { const size_t off_ = (size_t)(row0 + ((r) >> 2) * HALF + ((r) & 3) * 16) * DM + col0; \
            xv[slot][0][0] = __builtin_nontemporal_load((const f32x4*)(x + off_)); xv[slot][0][1] = __builtin_nontemporal_load((const f32x4*)(x + off_ + 4)); xv[slot][1][0] = __builtin_nontemporal_load((const f32x4*)(x + off_ + HALF)); xv[slot][1][1] = __builtin_nontemporal_load((const f32x4*)(x + off_ + HALF + 4)); } while (0)
        EO_LOAD(0, 0);
#pragma unroll
        for (int r = 0; r < 8; ++r) {
            const int sl = r & 1, ai = r >> 2, m = r & 3;
            if (r + 1 < 8) { EO_LOAD(sl ^ 1, r + 1); }
            const int row = row0 + ai * HALF + m * 16; float s_ = 0.f;
#pragma unroll
            for (int bj = 0; bj < 2; ++bj)
#pragma unroll
                for (int n = 0; n < 2; ++n) { const f32x4 o = xv[sl][bj][n] + gt[bj][n] * acc[ai][bj][m][n]; acc[ai][bj][m][n] = o;
                    s_ += (o[0] * o[0] + o[1] * o[1]) + (o[2] * o[2] + o[3] * o[3]); }
            s_ += __shfl_xor(s_, 16); s_ += __shfl_xor(s_, 32);
            if (fq == 0) __hip_atomic_store(ssq2 + (size_t)row * 16 + u.pn * 4 + wc, s_, __ATOMIC_RELAXED, __HIP_MEMORY_SCOPE_AGENT); }
#undef EO_LOAD
        asm volatile("s_waitcnt vmcnt(0)" ::: "memory");
        unsigned* pc = cnt + 64 * u.pm;
        if ((fr | fq) == 0) __hip_atomic_fetch_add(pc, 1u, __ATOMIC_RELAXED, __HIP_MEMORY_SCOPE_AGENT);
        { unsigned spins = 0;
          while ((unsigned)__builtin_amdgcn_readfirstlane(__hip_atomic_load(pc, __ATOMIC_RELAXED, __HIP_MEMORY_SCOPE_AGENT)) < 32u) { __builtin_amdgcn_s_sleep(1); if (++spins > (1u << 22)) break; } }
        __builtin_amdgcn_fence(__ATOMIC_ACQUIRE, "agent");
        f32x4 fw[2][2];
#pragma unroll
        for (int bj = 0; bj < 2; ++bj)
#pragma unroll
            for (int n = 0; n < 2; ++n) fw[bj][n] = *(const f32x4*)(fnw + col0 + bj * HALF + 4 * n);
#pragma unroll
        for (int r = 0; r < 8; ++r) {
            const int ai = r >> 2, m = r & 3; const int row = row0 + ai * HALF + m * 16; const size_t off = (size_t)row * DM + col0;
            const f32x4* sp = (const f32x4*)(ssq2 + (size_t)row * 16); const f32x4 a = sp[0], b = sp[1], c = sp[2], d = sp[3];
            const float t = ((a[0] + a[1]) + (a[2] + a[3])) + ((b[0] + b[1]) + (b[2] + b[3])) + ((c[0] + c[1]) + (c[2] + c[3])) + ((d[0] + d[1]) + (d[2] + d[3]));
            const float rstd = rsqrtf(t * (1.f / 1024.f) + EPS);
#pragma unroll
            for (int bj = 0; bj < 2; ++bj)
#pragma unroll
                for (int n = 0; n < 2; ++n) __builtin_nontemporal_store(acc[ai][bj][m][n] * rstd * fw[bj][n], (f32x4*)(out + off + bj * HALF + 4 * n)); }
    }
};
}

namespace att {
constexpr int D = 128, LD = LDP, NW = 8, QBLK = 32, KVBLK = 64, QB = NW * QBLK;
constexpr int SHM_V = KVBLK * D * 2, SHM_K = KVBLK * D * 2;
constexpr int F_OFF = 2 * SHM_V + 2 * SHM_K + NW * 64 * 4;
constexpr int ATT_LDS = F_OFF + 512;
constexpr float SCALE = 0.08838834764831845f;
constexpr float C2 = LOG2E * SCALE;
constexpr float THR2 = 12.f * LOG2E;
#define KSWZ(row, colB) ((row) * 256 + ((colB) ^ (((row) & 7) << 4)))
#define SBAR() __builtin_amdgcn_sched_barrier(0)
__device__ __forceinline__ int v_st(int k, int c) { const int kk = (k & ~0xC) | ((k & 4) << 1) | ((k & 8) >> 1); return ((kk >> 3) * 4 + (c >> 5)) * 512 + ((kk & 7) * 32 + (c & 31)) * 2; }
__device__ __forceinline__ int v_rd_base(int lane) { return ((lane & 3) << 3) | (((lane >> 2) & 3) << 6) | (((lane >> 4) & 1) << 5) | (((lane >> 5) & 1) << 8); }
constexpr int v_rd_off(int d0, int ks, int half) { return d0 * 512 + ks * 4096 + half * 2048; }
__device__ __forceinline__ int crow(int r, int hi) { return (r & 3) + 8 * (r >> 2) + 4 * hi; }
__device__ __forceinline__ bf16x8 load8(const bf16_t* p) { return *reinterpret_cast<const bf16x8*>(p); }
__device__ __forceinline__ void mask_tile(f32x16& p0, f32x16& p1, int dq) {
    const float NEG = -__builtin_inff();
#pragma unroll
    for (int r = 0; r < 16; ++r) {
        const int c = (r & 3) + 8 * (r >> 2);
        if (dq - c < 0) p0[r] = NEG;
        if (dq - c - 32 < 0) p1[r] = NEG;
    }
}
typedef float f32x8 __attribute__((ext_vector_type(8)));
__device__ __forceinline__ void partialSM(f32x16& p0, f32x16& p1, float& m_reg, float& mn, float& alpha, const char* fl) {
    { const f32x4 a = *(const f32x4*)(fl), b = *(const f32x4*)(fl + 32), c = *(const f32x4*)(fl + 64), d = *(const f32x4*)(fl + 96);
      const f32x16 fb = {a[0], a[1], a[2], a[3], b[0], b[1], b[2], b[3], c[0], c[1], c[2], c[3], d[0], d[1], d[2], d[3]};
      p0 = p0 * C2 + fb; }
    { const f32x4 a = *(const f32x4*)(fl + 128), b = *(const f32x4*)(fl + 160), c = *(const f32x4*)(fl + 192), d = *(const f32x4*)(fl + 224);
      const f32x16 fb = {a[0], a[1], a[2], a[3], b[0], b[1], b[2], b[3], c[0], c[1], c[2], c[3], d[0], d[1], d[2], d[3]};
      p1 = p1 * C2 + fb; }
    float pmax = p0[0];
#pragma unroll
    for (int r = 1; r < 16; ++r) pmax = fmaxf(pmax, p0[r]);
#pragma unroll
    for (int r = 0; r < 16; ++r) pmax = fmaxf(pmax, p1[r]);
    { auto rr = __builtin_amdgcn_permlane32_swap(__float_as_uint(pmax), __float_as_uint(pmax), false, false);
      pmax = fmaxf(__uint_as_float(rr[0]), __uint_as_float(rr[1])); }
    if (__builtin_expect(__all((pmax - m_reg) <= THR2), 1)) { mn = m_reg; alpha = 1.f; }
    else { mn = fmaxf(m_reg, pmax); alpha = __builtin_amdgcn_exp2f(m_reg - mn); m_reg = mn; }
    p0 = p0 - mn; p1 = p1 - mn;
#pragma unroll
    for (int r = 0; r < 16; ++r) p0[r] = __builtin_amdgcn_exp2f(p0[r]);
}
__device__ __forceinline__ void finishSM(f32x16& p0, f32x16& p1, float alpha, float& l_reg, bf16x8& pa0, bf16x8& pa1, bf16x8& pa2, bf16x8& pa3) {
#pragma unroll
    for (int r = 0; r < 16; ++r) p1[r] = __builtin_amdgcn_exp2f(p1[r]);
    float ps;
    { const f32x16 s16 = p0 + p1; const f32x8 s8 = s16.lo + s16.hi; const f32x4 s4 = s8.lo + s8.hi; const f32x2 s2 = s4.lo + s4.hi; ps = s2.x + s2.y; }
    { auto rr = __builtin_amdgcn_permlane32_swap(__float_as_uint(ps), __float_as_uint(ps), false, false);
      ps = __uint_as_float(rr[0]) + __uint_as_float(rr[1]); }
    l_reg = l_reg * alpha + ps;
#define PK4(P, B_, OUT) do { unsigned a0 = cvt_pk_bf16(P[B_+0], P[B_+1]), a1 = cvt_pk_bf16(P[B_+2], P[B_+3]);                          \
        unsigned b0 = cvt_pk_bf16(P[B_+4], P[B_+5]), b1 = cvt_pk_bf16(P[B_+6], P[B_+7]);                                             \
        auto r0 = __builtin_amdgcn_permlane32_swap(a0, b0, false, false); auto r1 = __builtin_amdgcn_permlane32_swap(a1, b1, false, false); \
        u32x4 w = {r0[0], r1[0], r0[1], r1[1]}; OUT = *reinterpret_cast<bf16x8*>(&w); } while (0)
    PK4(p0, 0, pa0); PK4(p0, 8, pa1); PK4(p1, 0, pa2); PK4(p1, 8, pa3);
#undef PK4
}
template <int KB>
__device__ __forceinline__ void qkt(f32x16& p0, f32x16& p1, const char* K_lds, int r32, int hi, const bf16x8* qr) {
    p0 = f32x16{}; p1 = f32x16{};
    const char* kb[4];
#pragma unroll
    for (int dd = 0; dd < 4; ++dd) kb[dd] = K_lds + KB * SHM_K + KSWZ(r32, (dd * 16 + hi * 8) * 2);
#pragma unroll
    for (int d0 = 0; d0 < 8; ++d0) { const char* a = kb[d0 & 3] + (d0 >> 2) * 128;
        bf16x8 b0 = *reinterpret_cast<const bf16x8*>(a);
        bf16x8 b1 = *reinterpret_cast<const bf16x8*>(a + 32 * 256);
        __builtin_amdgcn_s_setprio(1);
        p0 = __builtin_amdgcn_mfma_f32_32x32x16_bf16(b0, qr[d0], p0, 0, 0, 0);
        p1 = __builtin_amdgcn_mfma_f32_32x32x16_bf16(b1, qr[d0], p1, 0, 0, 0);
        __builtin_amdgcn_s_setprio(0); }
}
template <int VB>
__device__ __forceinline__ void pv_tile(f32x16* o, int vb0, bf16x8 pa0, bf16x8 pa1, bf16x8 pa2, bf16x8 pa3) {
#define TRRD(dst, off) asm volatile("ds_read_b64_tr_b16 %0, %1 offset:%2" : "=&v"(dst) : "v"(vb0), "i"(off) : "memory")
#define PV_D0(d0) do { s16x4 l0, l1, l2, l3, h0, h1, h2, h3; constexpr int b_ = VB * SHM_V + v_rd_off(d0, 0, 0); \
        TRRD(l0, b_); TRRD(h0, b_ + 2048); TRRD(l1, b_ + 4096); TRRD(h1, b_ + 6144); TRRD(l2, b_ + 8192); TRRD(h2, b_ + 10240); TRRD(l3, b_ + 12288); TRRD(h3, b_ + 14336); \
        asm volatile("s_waitcnt lgkmcnt(0)" ::: "memory"); SBAR(); __builtin_amdgcn_s_setprio(1);  \
        o[d0] = __builtin_amdgcn_mfma_f32_32x32x16_bf16(pa0, (bf16x8){l0[0], l0[1], l0[2], l0[3], h0[0], h0[1], h0[2], h0[3]}, o[d0], 0, 0, 0);   \
        o[d0] = __builtin_amdgcn_mfma_f32_32x32x16_bf16(pa1, (bf16x8){l1[0], l1[1], l1[2], l1[3], h1[0], h1[1], h1[2], h1[3]}, o[d0], 0, 0, 0);   \
        o[d0] = __builtin_amdgcn_mfma_f32_32x32x16_bf16(pa2, (bf16x8){l2[0], l2[1], l2[2], l2[3], h2[0], h2[1], h2[2], h2[3]}, o[d0], 0, 0, 0);   \
        o[d0] = __builtin_amdgcn_mfma_f32_32x32x16_bf16(pa3, (bf16x8){l3[0], l3[1], l3[2], l3[3], h3[0], h3[1], h3[2], h3[3]}, o[d0], 0, 0, 0); __builtin_amdgcn_s_setprio(0); } while (0)
    PV_D0(0); PV_D0(1); PV_D0(2); PV_D0(3);
#undef PV_D0
#undef TRRD
}
struct BlockRef { const bf16_t* Q; const bf16_t* K; const bf16_t* V; bf16_t* O; const float* F; float fref; int P0; int jlo; };
struct Seam { bf16x8 qr[8]; bf16x8 st_v0, st_v1, st_k0, st_k1; float st_f; };
#define ROW(p, k0, rr) ((p) + (size_t)((k0) + (rr)) * LD + sc)
#define VMW() asm volatile("s_waitcnt vmcnt(0)" ::: "memory")
#define VMWN(n) asm volatile("s_waitcnt vmcnt(%0)" :: "i"(n) : "memory")
#define SLOAD_H(Kp, Vp, Fp, k0) do { S.st_v0 = load8(ROW(Vp, k0, sr)); S.st_v1 = load8(ROW(Vp, k0, 32 + sr));              \
                         S.st_k0 = load8(ROW(Kp, k0, sr)); S.st_k1 = load8(ROW(Kp, k0, 32 + sr)); S.st_f = (Fp)[(k0) + (tid & 63)]; } while (0)
#define SWRITE_HK(bf, fr_) do { *(bf16x8*)(K_lds + (bf) * SHM_K + kws) = S.st_k0; *(bf16x8*)(K_lds + (bf) * SHM_K + kws + 32 * 256) = S.st_k1; \
                         if (tid < 64) *(float*)(F_lds + (bf) * 256 + tid * 4) = (fr_) - S.st_f; } while (0)
#define SWRITE_HV(bf) do { *(bf16x8*)(V_lds + (bf) * SHM_V + vst0) = S.st_v0; *(bf16x8*)(V_lds + (bf) * SHM_V + vst1) = S.st_v1; } while (0)
#define SWRITE_H(bf, fr_) do { SWRITE_HV(bf); SWRITE_HK(bf, fr_); } while (0)
__device__ __forceinline__ void attn_prime(const BlockRef& cur, char* lds, Seam& S, const int wid) {
    const int lane = fresh_lane(), tid = wid * 64 + lane, r32 = lane & 31, hi = lane >> 5;
    const int sr = tid >> 4, sc = (tid & 15) * 8, kws = KSWZ(sr, sc * 2); char* K_lds = lds + 2 * SHM_V; char* F_lds = lds + F_OFF;
#pragma unroll
    for (int d0 = 0; d0 < 8; ++d0) S.qr[d0] = load8(cur.Q + (size_t)(wid * QBLK + r32) * LD + d0 * 16 + hi * 8);
    SLOAD_H(cur.K, cur.V, cur.F, cur.jlo * KVBLK); VMW(); SWRITE_HK(0, cur.fref);
    __syncthreads();
}
__device__ __forceinline__ void attn_block(const BlockRef& cur, const BlockRef& nxt, char* lds, Seam& S, const int wid) {
    const int lane = fresh_lane(), tid = wid * 64 + lane; const int r32 = lane & 31, hi = lane >> 5;
    const int j_lo = cur.jlo;
    const int NT = (cur.P0 + QB - 1) / KVBLK + 1 - j_lo;
    const int kbn = nxt.jlo * KVBLK;
    const int qlo = cur.P0 + wid * QBLK, qm = qlo + r32 - 4 * hi;
    char* V_lds = lds; char* K_lds = lds + 2 * SHM_V; char* F_lds = lds + F_OFF;
    float* ws = (float*)(lds + 2 * SHM_V + 2 * SHM_K) + wid * 64; float* li_l = ws, * al_l = ws + 32;
    float m_reg = -1e30f, l_reg = 0; f32x16 o[4] = {};
    const int sr = tid >> 4, sc = (tid & 15) * 8, vst0 = v_st(sr, sc), vst1 = v_st(32 + sr, sc), kws = KSWZ(sr, sc * 2);
    const int vb0 = (int)(uintptr_t)V_lds + v_rd_base(lane);
    const char* flr = F_lds + 16 * hi;
    const bf16_t* Kh = cur.K; const bf16_t* Vh = cur.V; const float* Fh = cur.F; const float fref = cur.fref;
#define RESC(a) do { if (__any((a) < 1.f)) { if (hi == 0) al_l[r32] = (a); asm volatile("s_waitcnt lgkmcnt(0)" ::: "memory");              \
                     for (int d_ = 0; d_ < 4; ++d_) for (int r = 0; r < 16; ++r) o[d_][r] *= al_l[crow(r, hi)]; } } while (0)
#define KBASE(t) ((j_lo + (t)) * KVBLK)
#define MASKT(P0_, P1_, t) do { const int kb_ = KBASE(t); if (kb_ + KVBLK - 1 > qlo) mask_tile(P0_, P1_, qm - kb_); } while (0)
#define SEAM_K0() do { VMWN(8); SWRITE_HK(0, nxt.fref); SBAR(); } while (0)
    f32x16 pA0, pA1, pB0, pB1; float mnA, mnB, alA, alB; bf16x8 pa0, pa1, pa2, pa3;
    SWRITE_HV(0); SBAR();
    if (NT > 1) { SLOAD_H(Kh, Vh, Fh, KBASE(1)); }
    SBAR(); qkt<0>(pA0, pA1, K_lds, r32, hi, S.qr);
    MASKT(pA0, pA1, 0); partialSM(pA0, pA1, m_reg, mnA, alA, flr);
    if (NT > 1) { VMW(); SWRITE_H(1, fref); }
    __syncthreads();
#define HALF_STEP(PX0, PX1, mnX, alX, PY0, PY1, alY, t, KB, VB, SB) do {                                                      \
        SBAR(); qkt<KB>(PX0, PX1, K_lds, r32, hi, S.qr);                                             \
        finishSM(PY0, PY1, alY, l_reg, pa0, pa1, pa2, pa3); SBAR();                                                           \
        if ((t) + 1 < NT) { SLOAD_H(Kh, Vh, Fh, KBASE((t) + 1)); SBAR(); }                                               \
        pv_tile<VB>(o, vb0, pa0, pa1, pa2, pa3); MASKT(PX0, PX1, (t)); partialSM(PX0, PX1, m_reg, mnX, alX, flr + (KB) * 256);       \
        __syncthreads();                                                                                                      \
        if ((t) + 1 < NT) { VMW(); SWRITE_H(SB, fref); }                                                                          \
        RESC(alX); __syncthreads(); } while (0)
    for (int t = 1; t + 1 < NT; t += 2) {
        HALF_STEP(pB0, pB1, mnB, alB, pA0, pA1, alA, t, 1, 0, 0);
        HALF_STEP(pA0, pA1, mnA, alA, pB0, pB1, alB, t + 1, 0, 1, 1);
    }
    const bool even = (NT & 1) == 0;
    if (even) { SBAR(); qkt<1>(pB0, pB1, K_lds, r32, hi, S.qr); SBAR(); }
    SLOAD_H(nxt.K, nxt.V, nxt.F, kbn); SBAR();
#pragma unroll
    for (int d0 = 0; d0 < 8; ++d0) S.qr[d0] = load8(nxt.Q + (size_t)(wid * QBLK + r32) * LD + d0 * 16 + hi * 8);
    SBAR();
    finishSM(pA0, pA1, alA, l_reg, pa0, pa1, pa2, pa3); SBAR();
    pv_tile<0>(o, vb0, pa0, pa1, pa2, pa3);
    if (even) { MASKT(pB0, pB1, NT - 1); partialSM(pB0, pB1, m_reg, mnB, alB, flr + 256); __syncthreads(); RESC(alB);
        finishSM(pB0, pB1, alB, l_reg, pa0, pa1, pa2, pa3); SBAR(); pv_tile<1>(o, vb0, pa0, pa1, pa2, pa3); }
    SBAR(); SEAM_K0();
    if (hi == 0) li_l[r32] = l_reg; asm volatile("s_waitcnt lgkmcnt(0)" ::: "memory");
    float rli[16];
#pragma unroll
    for (int r = 0; r < 16; ++r) rli[r] = __builtin_amdgcn_rcpf(li_l[crow(r, hi)]);
    bf16_t* Ow = cur.O + (size_t)(wid * QBLK) * LD;
#pragma unroll
    for (int hf = 0; hf < 2; ++hf) {
        float zz[16][2];
#pragma unroll
        for (int r = 0; r < 16; ++r)
#pragma unroll
            for (int dd = 0; dd < 2; ++dd) zz[r][dd] = bf2f(Ow[(size_t)crow(r, hi) * LD + (hf * 2 + dd) * 32 + r32]);
        asm volatile("" ::: "memory");
#pragma unroll
        for (int r = 0; r < 16; ++r)
#pragma unroll
            for (int dd = 0; dd < 2; ++dd) { const int d0 = hf * 2 + dd; bf16_t* op = Ow + (size_t)crow(r, hi) * LD + d0 * 32 + r32;
                const float v = o[d0][r] * rli[r] * siluf_(zz[r][dd]);
                const float vn = __builtin_bit_cast(float, __builtin_amdgcn_update_dpp(0, __builtin_bit_cast(int, v), 0xB1, 0xf, 0xf, true));
                if ((r32 & 1) == 0) *(unsigned*)op = cvt_pk_bf16(v, vn); }
        asm volatile("" ::: "memory");
    }
    __syncthreads();
#undef RESC
#undef KBASE
#undef MASKT
#undef SEAM_K0
#undef HALF_STEP
}
#undef ROW
#undef VMW
#undef VMWN
#undef SLOAD_H
#undef SWRITE_HK
#undef SWRITE_HV
#undef SWRITE_H
#undef KSWZ
}

__device__ __forceinline__ void transpose_item(const float* W, int ldw, int srccol0, bf16_t* WT, int dstrow0, int k0, const float* kscale, LAS float* scr, int lane) {
#pragma unroll 8
    for (int i = 0; i < 32; ++i) { const int kk = 2 * i + (lane >> 5); float v = W[(size_t)(k0 + kk) * ldw + srccol0 + (lane & 31)]; if (kscale) v *= kscale[k0 + kk]; scr[kk * 33 + (lane & 31)] = v; }
    LDS_WAIT(); asm volatile("" ::: "memory");
    const int c = lane & 7;
#pragma unroll
    for (int j = 0; j < 4; ++j) { const int n = (lane >> 3) + 8 * j; const LAS float* s = scr + (8 * c) * 33 + n;
        u32x4 o; o.x = cvt_pk_bf16(s[0 * 33], s[1 * 33]); o.y = cvt_pk_bf16(s[2 * 33], s[3 * 33]); o.z = cvt_pk_bf16(s[4 * 33], s[5 * 33]); o.w = cvt_pk_bf16(s[6 * 33], s[7 * 33]);
        *(u32x4*)(WT + (size_t)(dstrow0 + n) * 1024 + k0 + 8 * c) = o; }
    LDS_WAIT(); asm volatile("" ::: "memory");
}

__device__ __forceinline__ void phase0(const Params& p, unsigned char* lds, int tid, int lane, int wave) {
    float* ada = (float*)(p.ws + WS_ADA);
    float* red = (float*)(lds + 131072);
    const int G = gridDim.x;
    for (int it = blockIdx.x; it < 256; it += G) {
        const int col0 = it * 12;
        float acc[4][12];
#pragma unroll
        for (int b = 0; b < 4; ++b)
#pragma unroll
            for (int j = 0; j < 12; ++j) acc[b][j] = 0.f;
#pragma unroll
        for (int rr = 0; rr < 2; ++rr) {
            const int row = wave * 128 + rr * 64 + lane;
            const f32x4* wp = (const f32x4*)(p.w_ada + (size_t)row * 3072 + col0);
            const f32x4 w0 = wp[0], w1 = wp[1], w2 = wp[2];
#pragma unroll
            for (int b = 0; b < 4; ++b) { const float s = siluf_(p.c[b * 1024 + row]);
#pragma unroll
                for (int j = 0; j < 4; ++j) { acc[b][j] += s * w0[j]; acc[b][4 + j] += s * w1[j]; acc[b][8 + j] += s * w2[j]; } }
        }
#pragma unroll
        for (int b = 0; b < 4; ++b)
#pragma unroll
            for (int j = 0; j < 12; ++j) { const float s = wave_sum(acc[b][j]); if (lane == 0) red[wave * 48 + b * 12 + j] = s; }
        __syncthreads();
        if (tid < 48) { float s = 0.f;
#pragma unroll
            for (int w = 0; w < 8; ++w) s += red[w * 48 + tid];
            const int b = tid / 12, j = tid % 12; ada[b * 3072 + col0 + j] = s + p.b_ada[col0 + j]; }
        __syncthreads();
    }
    if (blockIdx.x == 1 && tid < 128) ((unsigned*)(p.ws + WS_PCNT))[64 * tid] = 0u;
    if (blockIdx.x == 2) { for (int i = tid; i < 2048; i += NTHREADS) ((unsigned*)(p.ws + WS_QBD))[i] = (i & 1) ? 0x7fffffffu : 0u; }
    if (blockIdx.x == 0 && tid < 65) { if (tid < 64) ((unsigned*)(p.ws + WS_NORM2))[tid] = 0u; else { *(unsigned*)(p.ws + WS_QCTR) = 0u; ((unsigned*)(p.ws + WS_QCTR))[64] = 0u; } }
    { float* wsm = (float*)(p.ws + WS_WSMALL);
      for (int i = blockIdx.x * NTHREADS + tid; i < 24 * 1024; i += G * NTHREADS) { const int cc = i >> 10, k = i & 1023; const int src = cc < 16 ? 2304 + cc : 6416 + (cc - 16);
          wsm[i] = p.w_in[(size_t)k * IN_COLS + src]; } }
    LAS float* scr = (LAS float*)((LAS unsigned char*)lds + wave * 16384);
    const int gw = blockIdx.x * 8 + wave, NGW = G * 8;
    constexpr int I_IN = 264 * 16, I_P = 32 * 16;
    for (int it = gw; it < I_IN + 3 * I_P; it += NGW) {
        int r = it;
        if (r < I_IN) { const int nb = r >> 4, kb = r & 15; const int d0 = nb * 32; const int s0 = d0 < 2304 ? d0 : (d0 < 6400 ? d0 + 16 : d0 + 24);
            transpose_item(p.w_in, IN_COLS, s0, (bf16_t*)(p.ws + WS_WIN), d0, kb * 64, nullptr, scr, lane); continue; }
        r -= I_IN;
        if (r < I_P) { transpose_item(p.w_proj_ssm, 1024, (r >> 4) * 32, (bf16_t*)(p.ws + WS_WP), (r >> 4) * 32, (r & 15) * 64, p.ssm_norm_w, scr, lane); continue; }
        r -= I_P;
        if (r < I_P) { transpose_item(p.w_proj_att, 1024, (r >> 4) * 32, (bf16_t*)(p.ws + WS_WP), 1024 + (r >> 4) * 32, (r & 15) * 64, nullptr, scr, lane); continue; }
        r -= I_P;
        transpose_item(p.w_out, 1024, (r >> 4) * 32, (bf16_t*)(p.ws + WS_WOUT), (r >> 4) * 32, (r & 15) * 64, nullptr, scr, lane);
    }
}

constexpr int WPITCH = 1032;
__device__ __forceinline__ void phase1(const Params& p, unsigned char* lds, int tid, int lane, int wave) {
    const float* ada = (const float*)(p.ws + WS_ADA);
    const float* wsm = (const float*)(p.ws + WS_WSMALL);
    bf16_t* Whi = (bf16_t*)lds; bf16_t* Wlo = Whi + 24 * WPITCH;
    float* g1s = (float*)(lds + 2 * 24 * WPITCH * 2); float* shs = g1s + 1024;
    float* red = shs + 1024;
    f32x4* accp = (f32x4*)(red + 256);
    for (int i = tid; i < 24 * 1024; i += NTHREADS) { const float w = wsm[i]; const bf16_t hi = f2bf(w); const int c = i >> 10, k = i & 1023;
        Whi[c * WPITCH + k] = hi; Wlo[c * WPITCH + k] = f2bf(w - bf2f(hi)); }
    bf16_t* H = (bf16_t*)((unsigned char*)p.out + OUT_H);
    float* DT = (float*)(p.ws + WS_DT); float* LF = (float*)(p.ws + WS_LOGF);
    const int fr = lane & 15, fq = lane >> 4;
    const int c1 = (16 + fr) < 24 ? (16 + fr) : 23;
    const int kw = 128 * wave + 8 * fq;
    for (int base = blockIdx.x * 8; base < M / 16; base += gridDim.x * 8) {
        const int b = (base * 16) >> 13;
        __syncthreads();
        for (int i = tid; i < 1024; i += NTHREADS) { g1s[i] = p.norm_w[i] * (1.f + ada[b * 3072 + 1024 + i]); shs[i] = ada[b * 3072 + i]; }
        __syncthreads();
        f32x4 xa[4], xc[4];
        { const float* xr = p.x + (size_t)(base * 16 + fr) * DM + kw;
#pragma unroll
          for (int kk = 0; kk < 4; ++kk) { xa[kk] = __builtin_nontemporal_load((const f32x4*)(xr + 32 * kk)); xc[kk] = __builtin_nontemporal_load((const f32x4*)(xr + 32 * kk + 4)); } }
        for (int gi = 0; gi < 8; ++gi) {
            const int row0 = (base + gi) * 16, par = gi & 1;
            f32x4 na[4], nc[4];
            { const int gn = gi < 7 ? gi + 1 : 7; const float* xr = p.x + (size_t)((base + gn) * 16 + fr) * DM + kw;
#pragma unroll
              for (int kk = 0; kk < 4; ++kk) { na[kk] = __builtin_nontemporal_load((const f32x4*)(xr + 32 * kk)); nc[kk] = __builtin_nontemporal_load((const f32x4*)(xr + 32 * kk + 4)); } }
            float ss = 0.f;
#pragma unroll
            for (int kk = 0; kk < 4; ++kk) { const f32x4 a = xa[kk], c = xc[kk];
                ss += ((a[0] * a[0] + a[1] * a[1]) + (a[2] * a[2] + a[3] * a[3])) + ((c[0] * c[0] + c[1] * c[1]) + (c[2] * c[2] + c[3] * c[3])); }
            ss += __shfl_xor(ss, 16); ss += __shfl_xor(ss, 32);
            if (fq == 0) red[par * 128 + wave * 16 + fr] = ss;
            __syncthreads();
            float tot = 0.f;
#pragma unroll
            for (int w = 0; w < 8; ++w) tot += red[par * 128 + w * 16 + fr];
            const float rstd = rsqrtf(tot * (1.f / DM) + EPS);
            f32x4 acc0 = {0.f, 0.f, 0.f, 0.f}, acc1 = {0.f, 0.f, 0.f, 0.f};
            bf16_t* hr = H + (size_t)(row0 + fr) * DM + kw;
#pragma unroll
            for (int kk = 0; kk < 4; ++kk) {
                const int k = kw + 32 * kk;
                const f32x4 ga = *(const f32x4*)(g1s + k), gc = *(const f32x4*)(g1s + k + 4), sa = *(const f32x4*)(shs + k), sc = *(const f32x4*)(shs + k + 4);
                const f32x4 ha = xa[kk] * rstd * ga + sa, hc = xc[kk] * rstd * gc + sc;
                u32x4 hw; hw.x = cvt_pk_bf16(ha[0], ha[1]); hw.y = cvt_pk_bf16(ha[2], ha[3]); hw.z = cvt_pk_bf16(hc[0], hc[1]); hw.w = cvt_pk_bf16(hc[2], hc[3]);
                *(u32x4*)(hr + 32 * kk) = hw;
                u32x4 lw; lw.x = cvt_pk_bf16(ha[0] - bflo(hw.x), ha[1] - bfhi(hw.x)); lw.y = cvt_pk_bf16(ha[2] - bflo(hw.y), ha[3] - bfhi(hw.y));
                lw.z = cvt_pk_bf16(hc[0] - bflo(hw.z), hc[1] - bfhi(hw.z)); lw.w = cvt_pk_bf16(hc[2] - bflo(hw.w), hc[3] - bfhi(hw.w));
                const bf16x8 ahi = __builtin_bit_cast(bf16x8, hw), alo = __builtin_bit_cast(bf16x8, lw);
                const bf16x8 bh0 = *(const bf16x8*)(Whi + fr * WPITCH + k), bl0 = *(const bf16x8*)(Wlo + fr * WPITCH + k);
                const bf16x8 bh1 = *(const bf16x8*)(Whi + c1 * WPITCH + k), bl1 = *(const bf16x8*)(Wlo + c1 * WPITCH + k);
                acc0 = __builtin_amdgcn_mfma_f32_16x16x32_bf16(ahi, bh0, acc0, 0, 0, 0); acc0 = __builtin_amdgcn_mfma_f32_16x16x32_bf16(alo, bh0, acc0, 0, 0, 0); acc0 = __builtin_amdgcn_mfma_f32_16x16x32_bf16(ahi, bl0, acc0, 0, 0, 0);
                acc1 = __builtin_amdgcn_mfma_f32_16x16x32_bf16(ahi, bh1, acc1, 0, 0, 0); acc1 = __builtin_amdgcn_mfma_f32_16x16x32_bf16(alo, bh1, acc1, 0, 0, 0); acc1 = __builtin_amdgcn_mfma_f32_16x16x32_bf16(ahi, bl1, acc1, 0, 0, 0);
            }
            accp[((par * 8 + wave) * 2 + 0) * 64 + lane] = acc0; accp[((par * 8 + wave) * 2 + 1) * 64 + lane] = acc1;
            __syncthreads();
            if (wave < 2) {
                f32x4 t = accp[((par * 8 + 0) * 2 + wave) * 64 + lane];
#pragma unroll
                for (int w = 1; w < 8; ++w) t = t + accp[((par * 8 + w) * 2 + wave) * 64 + lane];
                if (wave == 0) { const float bdt = p.dt_bias[fr];
#pragma unroll
                    for (int j = 0; j < 4; ++j) { const float u = t[j] + bdt; DT[(size_t)(row0 + 4 * fq + j) * 16 + fr] = u > 20.f ? u : log1pf(__expf(u)); } }
                else if (fr < 8) { const float bff = p.b_f[fr];
#pragma unroll
                    for (int j = 0; j < 4; ++j) { const float u = t[j] + bff; LF[(size_t)(row0 + 4 * fq + j) * 8 + fr] = u < -20.f ? u : -log1pf(__expf(-u)); } }
            }
#pragma unroll
            for (int kk = 0; kk < 4; ++kk) { xa[kk] = na[kk]; xc[kk] = nc[kk]; }
        }
    }
    __syncthreads();
}

__device__ __forceinline__ void phase_fcum(const Params& p, unsigned char* lds, int tid, int lane, int wave) {
    const float* LF = (const float*)(p.ws + WS_LOGF); float* FL = (float*)(p.ws + WS_FL);
    float* wt = (float*)(lds + 131072);
    for (int s = (int)blockIdx.x - (gridDim.x >= 64 ? (int)gridDim.x / 2 : 0); s >= 0 && s < 32; s += gridDim.x) {
        const int b = s >> 3, h = s & 7; const int t0 = tid * 16;
        float v[16]; float run = 0.f;
#pragma unroll
        for (int i = 0; i < 16; ++i) { run += LF[((size_t)b * SEQ + t0 + i) * 8 + h]; v[i] = run; }
        float inc = run;
#pragma unroll
        for (int o = 1; o < 64; o <<= 1) { const float t = __shfl_up(inc, o); if (lane >= o) inc += t; }
        if (lane == 63) wt[wave] = inc;
        __syncthreads();
        float off = inc - run;
        for (int w = 0; w < wave; ++w) off += wt[w];
#pragma unroll
        for (int i = 0; i < 16; ++i) FL[(size_t)s * SEQ + t0 + i] = (v[i] + off) * LOG2E;
        __syncthreads();
    }
}

__device__ __forceinline__ void conv8_load(const bf16_t* xb, int tbase, int l0, int ch, bf16_t (&raw)[11]) {
#pragma unroll
    for (int i = 0; i < 11; ++i) { const int t = tbase + l0 - 3 + i; raw[i] = xb[(size_t)(t < 0 ? 0 : t) * LDP + ch]; }
}
__device__ __forceinline__ void conv8_fin(const bf16_t (&raw)[11], int tbase, int l0, int ch, const float* cw, const float* cb, float (&out)[8]) {
    const float w0 = cw[ch], w1 = cw[CONVD + ch], w2 = cw[2 * CONVD + ch], w3 = cw[3 * CONVD + ch], bb = cb[ch];
    float u[11];
#pragma unroll
    for (int i = 0; i < 11; ++i) { const int t = tbase + l0 - 3 + i; u[i] = (t >= 0) ? bf2f(raw[i]) : 0.f; }
#pragma unroll
    for (int i = 0; i < 8; ++i) { const float v = bb + w0 * u[i] + w1 * u[i + 1] + w2 * u[i + 2] + w3 * u[i + 3]; out[i] = siluf_(v); }
}
__device__ __forceinline__ void conv8(const bf16_t* xb, int tbase, int l0, int ch, const float* cw, const float* cb, float (&out)[8]) {
    bf16_t raw[11]; conv8_load(xb, tbase, l0, ch, raw); conv8_fin(raw, tbase, l0, ch, cw, cb, out);
}
__device__ __forceinline__ float wave_chunk_scan(const float* DT, size_t row0, int hd, float expA, float* w_acs, float* w_dt, int lane) {
    const float d0 = DT[(row0 + 2 * lane) * 16 + hd], d1 = DT[(row0 + 2 * lane + 1) * 16 + hd];
    const float a0 = -d0 * expA, a1 = -d1 * expA; float inc = a0 + a1;
#pragma unroll
    for (int o = 1; o < 64; o <<= 1) { const float t = __shfl_up(inc, o); if (lane >= o) inc += t; }
    *(f32x2*)(w_acs + 2 * lane) = (f32x2){inc - a1, inc}; *(f32x2*)(w_dt + 2 * lane) = (f32x2){d0, d1};
    return __shfl(inc, 63);
}
__device__ __forceinline__ bf16x8 pack8f(const float (&o)[8]) {
    u32x4 w; w.x = cvt_pk_bf16(o[0], o[1]); w.y = cvt_pk_bf16(o[2], o[3]); w.z = cvt_pk_bf16(o[4], o[5]); w.w = cvt_pk_bf16(o[6], o[7]);
    return __builtin_bit_cast(bf16x8, w);
}
constexpr int LT = 136;
constexpr int LN = 72;

__device__ __forceinline__ void phase_ssd_a(const Params& p, unsigned char* lds, int tid, int lane, int wave) {
    const bf16_t* P = (const bf16_t*)(p.ws + WS_P); const float* DT = (const float*)(p.ws + WS_DT);
    float* ST = (float*)((unsigned char*)p.out + OUT_ST); float* ACH = (float*)(p.ws + WS_ACH);
    float* w_acs = (float*)lds + wave * 256; float* w_dt = w_acs + 128;
    float* cwl = (float*)lds + 8 * 256;
    { float tw[13];
#pragma unroll
      for (int j = 0; j < 13; ++j) { const int i = tid + j * NTHREADS; tw[j] = i < 4 * CONVD ? p.conv_w[i] : (i < 5 * CONVD ? p.conv_b[i - 4 * CONVD] : 0.f); }
      asm volatile("" ::: "memory");
#pragma unroll
      for (int j = 0; j < 13; ++j) { const int i = tid + j * NTHREADS; if (i < 5 * CONVD) cwl[i] = tw[j]; } }
    __syncthreads();
    const int qk_ch = blockIdx.x * 8 + wave; int qk_row = 0; float mq0 = 0.f, mq1 = 0.f, mk0 = 0.f, mk1 = 0.f, dn0 = 3.0e38f, dn1 = 3.0e38f;
#define QK_LOAD() const bf16_t* rp_ = P + (size_t)(qk_ch * 16 + (qk_row < 15 ? qk_row : 15)) * LDP + 8 * lane; \
        const u32x4 qa_ = *(const u32x4*)(rp_ + OFF_Q), qb_ = *(const u32x4*)(rp_ + OFF_Q + 512), qc_ = *(const u32x4*)(rp_ + OFF_K), qd_ = *(const u32x4*)(rp_ + OFF_K + 512)
#define QK_SQ8(V_) ((bflo(V_.x) * bflo(V_.x) + bfhi(V_.x) * bfhi(V_.x)) + (bflo(V_.y) * bflo(V_.y) + bfhi(V_.y) * bfhi(V_.y)) + (bflo(V_.z) * bflo(V_.z) + bfhi(V_.z) * bfhi(V_.z)) + (bflo(V_.w) * bflo(V_.w) + bfhi(V_.w) * bfhi(V_.w)))
#define QK_DOT8(A_, B_) ((bflo(A_.x) * bflo(B_.x) + bfhi(A_.x) * bfhi(B_.x)) + (bflo(A_.y) * bflo(B_.y) + bfhi(A_.y) * bfhi(B_.y)) + (bflo(A_.z) * bflo(B_.z) + bfhi(A_.z) * bfhi(B_.z)) + (bflo(A_.w) * bflo(B_.w) + bfhi(A_.w) * bfhi(B_.w)))
#define QK_ROWSUM(v) do { v += DPPF(v, 0xB1); v += DPPF(v, 0x4E); v += DPPF(v, 0x141); v += DPPF(v, 0x140); } while (0)
#define QK_FIN() do { float sa_ = QK_SQ8(qa_), sb_ = QK_SQ8(qb_), sc_ = QK_SQ8(qc_), sd_ = QK_SQ8(qd_); float da_ = QK_DOT8(qa_, qc_), db_ = QK_DOT8(qb_, qd_); QK_ROWSUM(sa_); QK_ROWSUM(sb_); QK_ROWSUM(sc_); QK_ROWSUM(sd_); QK_ROWSUM(da_); QK_ROWSUM(db_); \
        if (qk_row < 16 && qk_ch < M / 16) { mq0 = fmaxf(mq0, sa_); mq1 = fmaxf(mq1, sb_); mk0 = fmaxf(mk0, sc_); mk1 = fmaxf(mk1, sd_); dn0 = fminf(dn0, da_); dn1 = fminf(dn1, db_); } ++qk_row; } while (0)
    for (int it = blockIdx.x; it < NB * NCH * 2; it += gridDim.x) {
        asm volatile("" : "+v"(lane));
        const int fr = lane & 15, fq = lane >> 4;
        const int g = it & 1, c = (it >> 1) & 63, b = it >> 7, hd = g * 8 + wave;
        const size_t row0 = (size_t)b * SEQ + c * CHUNK;
        const bf16_t* xb = P + (size_t)b * SEQ * LDP + OFF_XBC;
        const float atot = wave_chunk_scan(DT, row0, hd, __expf(p.a_log[hd]), w_acs, w_dt, lane);
        f32x4 acc[4][4];
#pragma unroll
        for (int a = 0; a < 4; ++a)
#pragma unroll
            for (int q = 0; q < 4; ++q) acc[a][q] = (f32x4){0.f, 0.f, 0.f, 0.f};
#pragma unroll 1
        for (int kk = 0; kk < 4; ++kk) {
            int l0 = 32 * kk + 8 * fq; asm volatile("" : "+v"(l0));
            const f32x4 ac0 = *(const f32x4*)(w_acs + l0), ac1 = *(const f32x4*)(w_acs + l0 + 4), dd0 = *(const f32x4*)(w_dt + l0), dd1 = *(const f32x4*)(w_dt + l0 + 4);
            float wv[8];
#pragma unroll
            for (int i = 0; i < 4; ++i) { wv[i] = dd0[i] * __expf(atot - ac0[i]); wv[4 + i] = dd1[i] * __expf(atot - ac1[i]); }
            bf16x8 af[4], bfr[4];
            { bf16_t rawx[4][11];
#pragma unroll
              for (int pt = 0; pt < 4; ++pt) conv8_load(xb, c * CHUNK, l0, hd * 64 + 16 * pt + fr, rawx[pt]);
              QK_LOAD();
              asm volatile("" ::: "memory");
              QK_FIN();
#pragma unroll
              for (int pt = 0; pt < 4; ++pt) { float o[8]; conv8_fin(rawx[pt], c * CHUNK, l0, hd * 64 + 16 * pt + fr, cwl, cwl + 4 * CONVD, o);
#pragma unroll
                  for (int i = 0; i < 8; ++i) o[i] *= wv[i];
                  af[pt] = pack8f(o); } }
            { bf16_t rawb[4][11];
#pragma unroll
              for (int nt = 0; nt < 4; ++nt) conv8_load(xb, c * CHUNK, l0, 1024 + g * 64 + 16 * nt + fr, rawb[nt]);
              QK_LOAD();
              asm volatile("" ::: "memory");
              QK_FIN();
#pragma unroll
              for (int nt = 0; nt < 4; ++nt) { float o[8]; conv8_fin(rawb[nt], c * CHUNK, l0, 1024 + g * 64 + 16 * nt + fr, cwl, cwl + 4 * CONVD, o); bfr[nt] = pack8f(o); } }
#pragma unroll
            for (int pt = 0; pt < 4; ++pt)
#pragma unroll
                for (int nt = 0; nt < 4; ++nt) acc[pt][nt] = __builtin_amdgcn_mfma_f32_16x16x32_bf16(af[pt], bfr[nt], acc[pt][nt], 0, 0, 0);
        }
        const int ih = (b * NCH + c) * NHS + hd;
        float* so = ST + (size_t)ih * 4096;
#pragma unroll
        for (int pt = 0; pt < 4; ++pt)
#pragma unroll
            for (int nt = 0; nt < 4; ++nt)
#pragma unroll
                for (int j = 0; j < 4; ++j) __builtin_nontemporal_store(acc[pt][nt][j], so + (16 * pt + 4 * fq + j) * 64 + 16 * nt + fr);
        if (lane == 0) ACH[ih] = atot;
    }
    while (qk_row < 16) { QK_LOAD(); QK_FIN(); }
#undef QK_LOAD
#undef QK_SQ8
#undef QK_DOT8
#undef QK_ROWSUM
#undef QK_FIN
    { float* red = (float*)(lds + 131072); unsigned* N2 = (unsigned*)(p.ws + WS_NORM2);
      float* redd = red + 128;
      if ((lane & 15) == 0) { const int h0 = lane >> 4; float* r = red + wave * 16; r[h0] = mq0; r[4 + h0] = mq1; r[8 + h0] = mk0; r[12 + h0] = mk1; redd[wave * 8 + h0] = dn0; redd[wave * 8 + 4 + h0] = dn1; }
      __syncthreads();
      if (wave == 0 && lane < 16 && blockIdx.x * 8 < M / 16) { float v = red[lane];
#pragma unroll
          for (int w = 1; w < 8; ++w) v = fmaxf(v, red[w * 16 + lane]);
          const int row_b = blockIdx.x * 128, b = row_b >> 13, qb = (row_b & (SEQ - 1)) >> 8;
          atomicMax(N2 + (b * 8 + (lane & 7)) * 2 + (lane >> 3), __float_as_uint(v));
          if (lane < 8) { float d = redd[lane];
#pragma unroll
              for (int w = 1; w < 8; ++w) d = fminf(d, redd[w * 8 + lane]);
              unsigned* qbd = (unsigned*)(p.ws + WS_QBD) + ((b * 8 + lane) * 32 + qb) * 2;
              atomicMax(qbd, __float_as_uint(v)); atomicMin((int*)qbd + 1, fkey(d)); } }
      __syncthreads(); }
}
__device__ __forceinline__ void phase_ssd_scan(const Params& p, int tid) {
    float* ST = (float*)((unsigned char*)p.out + OUT_ST); const float* ACH = (const float*)(p.ws + WS_ACH);
    for (int e = blockIdx.x * NTHREADS + tid; e < NB * NHS * 4096; e += gridDim.x * NTHREADS) {
        const int pn = e & 4095, hd = (e >> 12) & 15, b = e >> 16;
        float run = 0.f;
        float* sp = ST + ((size_t)(b * NCH) * NHS + hd) * 4096 + pn;
        const float* ap = ACH + (b * NCH) * NHS + hd;
        for (int c0 = 0; c0 < NCH; c0 += 32) { float s[32], a[32];
#pragma unroll
            for (int i = 0; i < 32; ++i) { s[i] = __builtin_nontemporal_load(sp + (size_t)(c0 + i) * NHS * 4096); a[i] = ap[(c0 + i) * NHS]; }
#pragma unroll
            for (int i = 0; i < 32; ++i) { __builtin_nontemporal_store(run, sp + (size_t)(c0 + i) * NHS * 4096); run = __expf(a[i]) * run + s[i]; } }
    }
}
__device__ __forceinline__ void phase_ssd_c(const Params& p, unsigned char* lds, int tid, int lane, int wave) {
    bf16_t* P = (bf16_t*)(p.ws + WS_P); const float* DT = (const float*)(p.ws + WS_DT);
    const float* ST = (const float*)((unsigned char*)p.out + OUT_ST); float* SSQ = (float*)(p.ws + WS_SSQ);
    bf16_t* cN = (bf16_t*)lds;
    bf16_t* bN = cN + 128 * LN;
    bf16_t* cbL = bN + 128 * LN;
    float* w_acs = (float*)(cbL + 128 * LT) + wave * 256; float* w_dt = w_acs + 128;
    float* cwl = (float*)(lds + 98304);
    { float tw[13];
#pragma unroll
      for (int j = 0; j < 13; ++j) { const int i = tid + j * NTHREADS; tw[j] = i < 4 * CONVD ? p.conv_w[i] : (i < 5 * CONVD ? p.conv_b[i - 4 * CONVD] : 0.f); }
      asm volatile("" ::: "memory");
#pragma unroll
      for (int j = 0; j < 13; ++j) { const int i = tid + j * NTHREADS; if (i < 5 * CONVD) cwl[i] = tw[j]; } }
    __syncthreads();
    for (int it = blockIdx.x; it < NB * NCH * 2; it += gridDim.x) {
        asm volatile("" : "+v"(lane));
        const int fr = lane & 15, fq = lane >> 4;
        const int g = it & 1, c = (it >> 1) & 63, b = it >> 7, hd = g * 8 + wave;
        const size_t row0 = (size_t)b * SEQ + c * CHUNK;
        const bf16_t* xb = P + (size_t)b * SEQ * LDP + OFF_XBC;
        bf16_t rawc[4][11];
#pragma unroll
        for (int uu = 0; uu < 4; ++uu) { const int unit = wave + 8 * uu, tens = unit >> 4, l0 = (unit & 15) * 8; conv8_load(xb, c * CHUNK, l0, 1024 + tens * 128 + g * 64 + lane, rawc[uu]); }
        asm volatile("" ::: "memory");
#pragma unroll
        for (int uu = 0; uu < 4; ++uu) { const int unit = wave + 8 * uu, tens = unit >> 4, l0 = (unit & 15) * 8; float o[8];
            conv8_fin(rawc[uu], c * CHUNK, l0, 1024 + tens * 128 + g * 64 + lane, cwl, cwl + 4 * CONVD, o);
            bf16_t* dst = tens ? cN : bN;
#pragma unroll
            for (int i = 0; i < 8; ++i) dst[(l0 + i) * LN + lane] = f2bf(o[i]); }
        (void)wave_chunk_scan(DT, row0, hd, __expf(p.a_log[hd]), w_acs, w_dt, lane);
        __syncthreads();
        { bf16x8 ca[2];
#pragma unroll
          for (int k = 0; k < 2; ++k) ca[k] = *(const bf16x8*)(cN + (16 * wave + fr) * LN + k * 32 + fq * 8);
#pragma unroll
          for (int ts = 0; ts < 8; ++ts) {
              if (ts <= wave + 1) { f32x4 cb = {0.f, 0.f, 0.f, 0.f};
#pragma unroll
                  for (int k = 0; k < 2; ++k) { const bf16x8 bb = *(const bf16x8*)(bN + (16 * ts + fr) * LN + k * 32 + fq * 8); cb = __builtin_amdgcn_mfma_f32_16x16x32_bf16(ca[k], bb, cb, 0, 0, 0); }
#pragma unroll
                  for (int j = 0; j < 4; ++j) cbL[(16 * wave + fq * 4 + j) * LT + 16 * ts + fr] = f2bf(cb[j]); } } }
        bf16x8 bx[4][4], sp[2][4];
#pragma unroll
        for (int kk = 0; kk < 4; ++kk) { bf16_t rawx[4][11];
#pragma unroll
            for (int pt = 0; pt < 4; ++pt) conv8_load(xb, c * CHUNK, 32 * kk + 8 * fq, hd * 64 + 16 * pt + fr, rawx[pt]);
            asm volatile("" ::: "memory");
#pragma unroll
            for (int pt = 0; pt < 4; ++pt) { float o[8]; conv8_fin(rawx[pt], c * CHUNK, 32 * kk + 8 * fq, hd * 64 + 16 * pt + fr, cwl, cwl + 4 * CONVD, o); bx[kk][pt] = pack8f(o); } }
        const int ih = (b * NCH + c) * NHS + hd;
#pragma unroll
        for (int k2 = 0; k2 < 2; ++k2) { f32x4 sr[4][2];
#pragma unroll
            for (int pt = 0; pt < 4; ++pt) { const float* q = ST + (size_t)ih * 4096 + (16 * pt + fr) * 64 + 32 * k2 + 8 * fq; sr[pt][0] = *(const f32x4*)q; sr[pt][1] = *(const f32x4*)(q + 4); }
            asm volatile("" ::: "memory");
#pragma unroll
            for (int pt = 0; pt < 4; ++pt) { const f32x4 s0 = sr[pt][0], s1 = sr[pt][1];
                u32x4 w; w.x = cvt_pk_bf16(s0[0], s0[1]); w.y = cvt_pk_bf16(s0[2], s0[3]); w.z = cvt_pk_bf16(s1[0], s1[1]); w.w = cvt_pk_bf16(s1[2], s1[3]); sp[k2][pt] = __builtin_bit_cast(bf16x8, w); } }
        const float dsk = p.d_skip[hd];
        __syncthreads();
#pragma unroll 1
        for (int lt = 0; lt < 8; ++lt) {
            float zv[4][4];
#pragma unroll
            for (int j = 0; j < 4; ++j)
#pragma unroll
                for (int pt = 0; pt < 4; ++pt) zv[j][pt] = bf2f(P[(row0 + 16 * lt + fq * 4 + j) * LDP + OFF_ZSSM + hd * 64 + 16 * pt + fr]);
            f32x4 acc[4];
#pragma unroll
            for (int pt = 0; pt < 4; ++pt) acc[pt] = (f32x4){0.f, 0.f, 0.f, 0.f};
            int l = 16 * lt + fr; asm volatile("" : "+v"(l)); const float al = w_acs[l];
#pragma unroll
            for (int kk = 0; kk < 4; ++kk) { if (32 * kk <= 16 * lt + 15) {
                const int s0 = 32 * kk + 8 * fq;
                const u32x4 cw4 = *(const u32x4*)(cbL + l * LT + s0);
                const f32x4 ac0 = *(const f32x4*)(w_acs + s0), ac1 = *(const f32x4*)(w_acs + s0 + 4), dd0 = *(const f32x4*)(w_dt + s0), dd1 = *(const f32x4*)(w_dt + s0 + 4);
                float v[8] = {bflo(cw4.x), bfhi(cw4.x), bflo(cw4.y), bfhi(cw4.y), bflo(cw4.z), bfhi(cw4.z), bflo(cw4.w), bfhi(cw4.w)};
#pragma unroll
                for (int i = 0; i < 4; ++i) { v[i] *= __expf(al - ac0[i]) * dd0[i]; v[4 + i] *= __expf(al - ac1[i]) * dd1[i]; }
#pragma unroll
                for (int i = 0; i < 8; ++i) { v[i] = (s0 + i <= l) ? v[i] : 0.f; if (s0 + i == l) v[i] += dsk; }
                const bf16x8 a = pack8f(v);
#pragma unroll
                for (int pt = 0; pt < 4; ++pt) acc[pt] = __builtin_amdgcn_mfma_f32_16x16x32_bf16(a, bx[kk][pt], acc[pt], 0, 0, 0); } }
            const float ea = __expf(al);
#pragma unroll
            for (int k2 = 0; k2 < 2; ++k2) { const u32x4 cw4 = *(const u32x4*)(cN + l * LN + 32 * k2 + 8 * fq);
                float v[8] = {bflo(cw4.x), bfhi(cw4.x), bflo(cw4.y), bfhi(cw4.y), bflo(cw4.z), bfhi(cw4.z), bflo(cw4.w), bfhi(cw4.w)};
#pragma unroll
                for (int i = 0; i < 8; ++i) v[i] *= ea;
                const bf16x8 a = pack8f(v);
#pragma unroll
                for (int pt = 0; pt < 4; ++pt) acc[pt] = __builtin_amdgcn_mfma_f32_16x16x32_bf16(a, sp[k2][pt], acc[pt], 0, 0, 0); }
#pragma unroll
            for (int j = 0; j < 4; ++j) { const size_t row = row0 + 16 * lt + fq * 4 + j; float sq = 0.f;
                bf16_t* zp = P + row * LDP + OFF_ZSSM + hd * 64;
#pragma unroll
                for (int pt = 0; pt < 4; ++pt) { const float yg = acc[pt][j] * siluf_(zv[j][pt]); sq += yg * yg; zp[16 * pt + fr] = f2bf(yg); }
                sq += DPPF(sq, 0xB1); sq += DPPF(sq, 0x4E); sq += DPPF(sq, 0x141); sq += DPPF(sq, 0x140);
                if (fr == 0) SSQ[row * 16 + hd] = sq; }
        }
        __syncthreads();
    }
}
__device__ __forceinline__ void phase_qknorm(const Params& p, int lane, int wave) {
    const bf16_t* P = (const bf16_t*)(p.ws + WS_P); unsigned* N2 = (unsigned*)(p.ws + WS_NORM2);
    const int gw = blockIdx.x * 8 + wave, NGW = gridDim.x * 8;
    for (int ch = gw + NGW; ch < M / 16; ch += NGW) {
        float mq0 = 0.f, mq1 = 0.f, mk0 = 0.f, mk1 = 0.f, dn0 = 3.0e38f, dn1 = 3.0e38f;
#pragma unroll 4
        for (int rr = 0; rr < 16; ++rr) {
            const bf16_t* rp = P + (size_t)(ch * 16 + rr) * LDP + 8 * lane;
            const u32x4 a = *(const u32x4*)(rp + OFF_Q), b = *(const u32x4*)(rp + OFF_Q + 512), c = *(const u32x4*)(rp + OFF_K), d = *(const u32x4*)(rp + OFF_K + 512);
#define SQ8(V_) ((bflo(V_.x) * bflo(V_.x) + bfhi(V_.x) * bfhi(V_.x)) + (bflo(V_.y) * bflo(V_.y) + bfhi(V_.y) * bfhi(V_.y)) + (bflo(V_.z) * bflo(V_.z) + bfhi(V_.z) * bfhi(V_.z)) + (bflo(V_.w) * bflo(V_.w) + bfhi(V_.w) * bfhi(V_.w)))
            float sa = SQ8(a), sb = SQ8(b), sc = SQ8(c), sd = SQ8(d);
#undef SQ8
#define DOT8(A_, B_) ((bflo(A_.x) * bflo(B_.x) + bfhi(A_.x) * bfhi(B_.x)) + (bflo(A_.y) * bflo(B_.y) + bfhi(A_.y) * bfhi(B_.y)) + (bflo(A_.z) * bflo(B_.z) + bfhi(A_.z) * bfhi(B_.z)) + (bflo(A_.w) * bflo(B_.w) + bfhi(A_.w) * bfhi(B_.w)))
            float da = DOT8(a, c), db = DOT8(b, d);
#undef DOT8
#define ROWSUM(v) do { v += DPPF(v, 0xB1); v += DPPF(v, 0x4E); v += DPPF(v, 0x141); v += DPPF(v, 0x140); } while (0)
            ROWSUM(sa); ROWSUM(sb); ROWSUM(sc); ROWSUM(sd); ROWSUM(da); ROWSUM(db);
#undef ROWSUM
            mq0 = fmaxf(mq0, sa); mq1 = fmaxf(mq1, sb); mk0 = fmaxf(mk0, sc); mk1 = fmaxf(mk1, sd); dn0 = fminf(dn0, da); dn1 = fminf(dn1, db);
        }
        if ((lane & 15) == 0) { const int b = (ch * 16) >> 13, h0 = lane >> 4;
            atomicMax(N2 + (b * 8 + h0) * 2 + 0, __float_as_uint(mq0)); atomicMax(N2 + (b * 8 + 4 + h0) * 2 + 0, __float_as_uint(mq1));
            atomicMax(N2 + (b * 8 + h0) * 2 + 1, __float_as_uint(mk0)); atomicMax(N2 + (b * 8 + 4 + h0) * 2 + 1, __float_as_uint(mk1));
            const int qb = ((ch * 16) & (SEQ - 1)) >> 8; unsigned* q0 = (unsigned*)(p.ws + WS_QBD) + ((b * 8 + h0) * 32 + qb) * 2; unsigned* q1 = (unsigned*)(p.ws + WS_QBD) + ((b * 8 + 4 + h0) * 32 + qb) * 2;
            atomicMax(q0, __float_as_uint(mq0)); atomicMin((int*)q0 + 1, fkey(dn0)); atomicMax(q1, __float_as_uint(mq1)); atomicMin((int*)q1 + 1, fkey(dn1)); }
    }
}
__device__ __forceinline__ void att_ref(att::BlockRef& r, bf16_t* P, const float* FL, int unit, int jlo) {
    const int bh = unit & 31, qb = 31 - (unit >> 5);
    const int b = bh >> 3, h = bh & 7; const size_t rowb = (size_t)b * SEQ;
    r.Q = P + (rowb + (size_t)qb * 256) * LDP + OFF_Q + h * 128; r.K = P + rowb * LDP + OFF_K + h * 128; r.V = P + rowb * LDP + OFF_V + h * 128;
    r.O = P + (rowb + (size_t)qb * 256) * LDP + OFF_ZATT + h * 128; r.F = FL + (size_t)bh * SEQ; r.P0 = qb * 256; r.fref = r.F[r.P0]; r.jlo = jlo;
}
__device__ __forceinline__ void att_pop(const Params& p, const float* FL, volatile int* slot, int lane) {
    asm volatile("" : "+v"(lane));
    unsigned u = 0; if (lane == 0) u = atomicAdd((unsigned*)(p.ws + WS_QCTR), 1u);
    u = __builtin_amdgcn_readfirstlane(u);
    int jlo = 0;
    if (u < 1024u) {
        const int bh = u & 31, qb = 31 - (int)(u >> 5), P0 = qb * 256, NTf = 4 * qb + 4;
        const unsigned* n2 = (const unsigned*)(p.ws + WS_NORM2) + bh * 2;
        const float q2 = __uint_as_float(n2[0]), k2 = __uint_as_float(n2[1]);
        const unsigned* qbd = (const unsigned*)(p.ws + WS_QBD) + (bh * 32 + qb) * 2;
        const float qb2 = __uint_as_float(qbd[0]); const int dk = (int)qbd[1];
        float thr = (106.f + 2.f * sqrtf(q2 * k2) * att::SCALE) * LOG2E;
        if (dk != 0x7fffffff && qb2 > 0.f) thr = (106.f + (sqrtf(qb2 * k2) - fkey_inv(dk)) * att::SCALE) * LOG2E;
        const float* F = FL + (size_t)bh * SEQ;
        const float bound = F[P0] + thr;
        const int t0 = 2 * lane, t1 = 2 * lane + 1;
        const float f0 = F[64 * (t0 < NTf ? t0 : NTf - 1) + 63], f1 = F[64 * (t1 < NTf ? t1 : NTf - 1) + 63];
        const unsigned long long b0 = __ballot(f0 < bound), b1 = __ballot(f1 < bound);
        const int g0 = b0 ? (int)__builtin_ctzll(b0) * 2 : 128, g1 = b1 ? (int)__builtin_ctzll(b1) * 2 + 1 : 128;
        jlo = g0 < g1 ? g0 : g1;
        if (jlo > NTf - 1) jlo = NTf - 1;
    }
    if (lane == 0) { slot[0] = (int)u; slot[1] = jlo; }
}
__device__ __forceinline__ void phase_attn(const Params& p, unsigned char* lds, int lane, int wave) {
    bf16_t* P = (bf16_t*)(p.ws + WS_P); const float* FL = (const float*)(p.ws + WS_FL);
    volatile int* slot = (volatile int*)(lds + att::ATT_LDS);
    if (wave == 0) att_pop(p, FL, slot, lane);
    __syncthreads();
    int u = __builtin_amdgcn_readfirstlane(slot[0]), jl = __builtin_amdgcn_readfirstlane(slot[1]);
    __syncthreads();
    if (u >= 1024) return;
    att::BlockRef cur; att_ref(cur, P, FL, u, jl);
    att::Seam S;
    att::attn_prime(cur, (char*)lds, S, wave);
    for (;;) {
        if (wave == 0) att_pop(p, FL, slot, lane);
        __syncthreads();
        const int un = __builtin_amdgcn_readfirstlane(slot[0]), jn = __builtin_amdgcn_readfirstlane(slot[1]);
        const bool last = un >= 1024;
        att::BlockRef nxt; if (last) nxt = cur; else att_ref(nxt, P, FL, un, jn);
        att::attn_block(cur, nxt, (char*)lds, S, wave);
        if (last) break;
        cur = nxt;
    }
}
__device__ __forceinline__ void phase_final(const Params& p, int lane, int wave) {
    const float* SSQ2 = (const float*)(p.ws + WS_SSQ2);
    const int gw = blockIdx.x * 8 + wave, NGW = gridDim.x * 8;
    f32x4 fw[4];
#pragma unroll
    for (int j = 0; j < 4; ++j) fw[j] = *(const f32x4*)(p.final_norm_w + 256 * j + 4 * lane);
    for (int m = gw; m < M; m += NGW) {
        const f32x4* sp = (const f32x4*)(SSQ2 + (size_t)m * 16); const f32x4 a = sp[0], b = sp[1], c = sp[2], d = sp[3];
        const float s = ((a[0] + a[1]) + (a[2] + a[3])) + ((b[0] + b[1]) + (b[2] + b[3])) + ((c[0] + c[1]) + (c[2] + c[3])) + ((d[0] + d[1]) + (d[2] + d[3]));
        const float rstd = rsqrtf(s * (1.f / DM) + EPS);
        f32x4* xr = (f32x4*)(p.out + (size_t)m * DM) + lane;
#pragma unroll
        for (int j = 0; j < 4; ++j) xr[64 * j] = xr[64 * j] * rstd * fw[j];
    }
}


__device__ __forceinline__ void phase_gemm1(const Params& p, unsigned char* lds, int tid, int lane, int wave) {
    bf16_t* P = (bf16_t*)(p.ws + WS_P);
    phase_fcum(p, lds, tid, lane, wave);
    pg8::Order<1, 4> S; S.init(M, NPROJ, gridDim.x, blockIdx.x);
    S.A0 = (const char*)p.out + OUT_H; S.A1 = S.A0; S.B = (const char*)(p.ws + WS_WIN); S.tstepA = (size_t)256 * DM * 2;
    pg8::EpiProj E{P, (bf16_t*)((unsigned char*)p.out + OUT_GATT)};
    pg8::gemm_phase<pg8::EpiProj, pg8::Order<1, 4>>((LAS unsigned char*)lds, DM, DM, S, E, wave);
}
__device__ __forceinline__ void phase_merge(const Params& p, unsigned char* lds, const int wave) {
    bf16_t* P = (bf16_t*)(p.ws + WS_P);
    pg8::Order<2> S; S.init(M, DM, gridDim.x, blockIdx.x);
    S.A0 = (const char*)(P + OFF_ZSSM); S.A1 = (const char*)(P + OFF_ZATT); S.B = (const char*)(p.ws + WS_WP); S.tstepA = (size_t)256 * LDP * 2;
    float* rtab = (float*)(lds + 131072);
    { const float* ssq = (const float*)(p.ws + WS_SSQ); const int tid = wave * 64 + fresh_lane();
      for (int slot = 0; slot < 16; ++slot) { pg8::Unit t; if (!S.next(slot * 2, t)) break;
          const f32x4* sp = (const f32x4*)(ssq + (size_t)(t.pm * 256 + (tid >> 1)) * 16 + (tid & 1) * 8); const f32x4 a = sp[0], b = sp[1];
          float v = ((a[0] + a[1]) + (a[2] + a[3])) + ((b[0] + b[1]) + (b[2] + b[3])); v += __shfl_xor(v, 1);
          if ((tid & 1) == 0) rtab[slot * 256 + (tid >> 1)] = rsqrtf(v * (1.f / 1024.f) + EPS); }
      __syncthreads(); }
    pg8::EpiMerge E{P + OFF_GSSM, (const bf16_t*)((unsigned char*)p.out + OUT_GATT), P + OFF_Q, rtab, p.b_gate};
    pg8::gemm_phase<pg8::EpiMerge, pg8::Order<2>>((LAS unsigned char*)lds, DM, LDP, S, E, wave);
}
__device__ __forceinline__ void phase_outg(const Params& p, unsigned char* lds, const int wave) {
    bf16_t* P = (bf16_t*)(p.ws + WS_P);
    pg8::Order<1> S; S.init(M, DM, gridDim.x, blockIdx.x);
    S.A0 = (const char*)(P + OFF_Q); S.A1 = S.A0; S.B = (const char*)(p.ws + WS_WOUT); S.tstepA = (size_t)256 * LDP * 2;
    pg8::EpiOutNorm E{p.x, p.out, (const float*)(p.ws + WS_ADA), (float*)(p.ws + WS_SSQ2), (unsigned*)(p.ws + WS_PCNT), p.final_norm_w};
    pg8::gemm_phase<pg8::EpiOutNorm, pg8::Order<1>>((LAS unsigned char*)lds, DM, LDP, S, E, wave);
}

constexpr int NPHASE = 8;
__global__ void __launch_bounds__(NTHREADS, 2) mega_fwd(Params p) {
    extern __shared__ __attribute__((aligned(16))) unsigned char lds[];
    const int wave = __builtin_amdgcn_readfirstlane(threadIdx.x >> 6);
#define FRESH() const int lane = fresh_lane(); const int tid = wave * 64 + lane; (void)tid; (void)lane
    const int lo = p.ph_lo, hi = p.ph_hi;
#define IN(k) (lo <= (k) && (k) < hi)
#define SEAM(k) do { if (IN(k) && IN((k) + 1)) { if ((k) == 0) cg::this_grid().sync(); else grid_barrier((unsigned*)(p.ws + WS_QCTR) + 64, (unsigned)(k) * gridDim.x, wave); } } while (0)
#ifndef PROBE_MASK
#define PROBE_MASK 0
#endif
#if PROBE_MASK & 1
    if (IN(0)) { FRESH(); phase0(p, lds, tid, lane, wave); }
#endif
    if (IN(0)) { FRESH(); phase0(p, lds, tid, lane, wave); }
    SEAM(0);
#if PROBE_MASK & 2
    if (IN(1)) { FRESH(); phase1(p, lds, tid, lane, wave); }
#endif
    if (IN(1)) { FRESH(); phase1(p, lds, tid, lane, wave); }
    SEAM(1);
#if PROBE_MASK & 4
    if (IN(2)) { FRESH(); phase_gemm1(p, lds, tid, lane, wave); }
#endif
    if (IN(2)) { FRESH(); phase_gemm1(p, lds, tid, lane, wave); }
    SEAM(2);
#if PROBE_MASK & 8
    if (IN(3)) { FRESH(); phase_ssd_a(p, lds, tid, lane, wave); }
#endif
    if (IN(3)) { { FRESH(); phase_ssd_a(p, lds, tid, lane, wave); } { FRESH(); phase_qknorm(p, lane, wave); } }
    SEAM(3);
    if (IN(4)) { { FRESH(); phase_ssd_scan(p, tid); } { FRESH(); phase_attn(p, lds, lane, wave); } }
    SEAM(4);
    if (IN(5)) { FRESH(); phase_ssd_c(p, lds, tid, lane, wave); }
    SEAM(5);
#if PROBE_MASK & 64
    if (IN(6)) { phase_merge(p, lds, wave); }
#endif
    if (IN(6)) { phase_merge(p, lds, wave); }
    SEAM(6);
#if PROBE_MASK & 128
    if (IN(7)) { phase_outg(p, lds, wave); }
#endif
    if (IN(7)) { phase_outg(p, lds, wave); }

#undef IN
#undef SEAM
}

extern "C" void kernel_launch(void* const* d_in, const int* in_sizes, int n_in, void* d_out, int out_size, void* d_ws, size_t ws_size, hipStream_t stream) {
    static int grid = 0;
    if (grid == 0) {
        if (n_in != 18 || out_size != M * DM || ws_size < WS_END) { fprintf(stderr, "kernel_launch: unexpected shapes (n_in %d out %d ws %zu)\n", n_in, out_size, ws_size); grid = -1; return; }
        int dev = 0, cus = 0, per_cu = 0;
        (void)hipGetDevice(&dev); (void)hipDeviceGetAttribute(&cus, hipDeviceAttributeMultiprocessorCount, dev);
        if (hipFuncSetAttribute((const void*)mega_fwd, hipFuncAttributeMaxDynamicSharedMemorySize, LDS_BYTES) != hipSuccess) { fprintf(stderr, "kernel_launch: hipFuncSetAttribute failed\n"); grid = -1; return; }
        if (hipOccupancyMaxActiveBlocksPerMultiprocessor(&per_cu, (const void*)mega_fwd, NTHREADS, LDS_BYTES) != hipSuccess || per_cu < 1) per_cu = 1;
        (void)hipGetLastError();
        grid = cus * per_cu; if (grid <= 0) grid = 256;
    }
    if (grid < 0) return;
    Params p{};
    const float** pp = (const float**)&p;
    for (int i = 0; i < 18; ++i) pp[i] = (const float*)d_in[i];
    p.out = (float*)d_out; p.ws = (unsigned char*)d_ws;
#if MK_N_LAUNCHES == 1
    p.ph_lo = 0; p.ph_hi = NPHASE;
    void* args[] = {&p};
    hipError_t e = hipLaunchCooperativeKernel((const void*)mega_fwd, dim3(grid), dim3(NTHREADS), args, LDS_BYTES, stream);
    if (e != hipSuccess) fprintf(stderr, "kernel_launch: cooperative launch failed: %s (grid %d)\n", hipGetErrorString(e), grid);
#else
    for (int ph = 0; ph < NPHASE; ++ph) { p.ph_lo = ph; p.ph_hi = ph + 1; hipLaunchKernelGGL(mega_fwd, dim3(grid), dim3(NTHREADS), LDS_BYTES, stream, p); }
#endif
}
```
